# Optimizing an MI355X kernel written in HIP

```python
import math
import jax, jax.numpy as jnp
from jax import lax
import numpy as np

D_MODEL = 1024
BATCH = 8
SEQ = 2048
DEPTH = 1

CHUNK = 64
SSD_HEADS = 16
SSD_HEAD_DIM = 64
SSD_INNER = SSD_HEADS * SSD_HEAD_DIM
SSD_GROUPS = 2
SSD_STATE = 128
SSD_CONV = 4
SSD_SCAN_CHUNK = CHUNK
CONV_DIM = SSD_INNER + 2 * SSD_GROUPS * SSD_STATE
SB_HEADS = 16
SB_HEAD_DIM = 64
SB_INNER = SB_HEADS * SB_HEAD_DIM
SB_BLOCK = 128
N_BRANCH = 2
IN_SIZES = (SSD_INNER, CONV_DIM, SSD_HEADS, SB_INNER, SB_INNER, SB_INNER, SB_INNER, N_BRANCH * D_MODEL)
IN_COLS = sum(IN_SIZES)
EPS = 1e-6

kernel_name = "hybrid_ssd_stickbreaking_gated_block"


def _split_points():
    pts, acc = [], 0
    for s in IN_SIZES[:-1]:
        acc += s
        pts.append(acc)
    return pts


def rmsnorm(x, w):
    xf = x.astype(jnp.float32)
    y = xf * lax.rsqrt(jnp.mean(xf * xf, axis=-1, keepdims=True) + EPS)
    return (y * w.astype(jnp.float32)).astype(x.dtype)


def gated_group_rmsnorm(y, z, w, groups):
    g = (y.astype(jnp.float32) * jax.nn.silu(z.astype(jnp.float32)))
    g = g.reshape(y.shape[:-1] + (groups, y.shape[-1] // groups))
    g = g * lax.rsqrt(jnp.mean(g * g, axis=-1, keepdims=True) + EPS)
    return (g.reshape(y.shape) * w.astype(jnp.float32)).astype(y.dtype)


def ssd_scan(xh, dt, a, bmat, cmat, d_skip):
    bsz, L, H, P = xh.shape
    G, N = bmat.shape[2], bmat.shape[3]
    R = H // G
    T = SSD_SCAN_CHUNK
    NC = L // T
    x_dt = (xh * dt[..., None]).reshape(bsz, NC, T, G, R, P)
    a_dt = jnp.transpose((dt * a).reshape(bsz, NC, T, G, R), (0, 3, 4, 1, 2))
    a_cs = jnp.cumsum(a_dt, axis=-1)
    bc = bmat.reshape(bsz, NC, T, G, N)
    cc = cmat.reshape(bsz, NC, T, G, N)
    seg = a_cs[..., :, None] - a_cs[..., None, :]
    causal = jnp.tril(jnp.ones((T, T), dtype=bool))
    decay = jnp.exp(jnp.where(causal, seg, -jnp.inf))
    scores = jnp.einsum('bclgn,bcsgn->bgcls', cc, bc)
    attn = scores[:, :, None] * decay
    y_diag = jnp.einsum('bgrcls,bcsgrp->bclgrp', attn, x_dt)
    decay_states = jnp.exp(a_cs[..., -1:] - a_cs)
    states = jnp.einsum('bclgn,bgrcl,bclgrp->bcgrpn', bc, decay_states, x_dt)
    chunk_decay = jnp.exp(a_cs[..., -1])

    def step(carry, inp):
        st, dec = inp
        new = carry * dec[..., None, None] + st
        return new, carry

    init = jnp.zeros((bsz, G, R, P, N), dtype=xh.dtype)
    _, prev = lax.scan(step, init, (jnp.moveaxis(states, 1, 0), jnp.moveaxis(chunk_decay, -1, 0)))
    prev = jnp.moveaxis(prev, 0, 1)
    y_off = jnp.einsum('bclgn,bcgrpn,bgrcl->bclgrp', cc, prev, jnp.exp(a_cs))
    y = (y_diag + y_off).reshape(bsz, L, H, P)
    return y + xh * d_skip[:, None]


def stick_breaking(q, k, v):
    bsz, L, H, Dh = q.shape
    scale = Dh ** -0.5
    outs = []
    for blk in range(L // SB_BLOCK):
        q0 = blk * SB_BLOCK
        kend = q0 + SB_BLOCK
        logits = jnp.einsum('bqhd,bkhd->bhqk', q[:, q0:kend], k[:, :kend]).astype(jnp.float32) * scale
        qi = q0 + jnp.arange(SB_BLOCK)[:, None]
        ki = jnp.arange(kend)[None, :]
        mask = ki < qi
        log_fail = jnp.where(mask, jax.nn.log_sigmoid(-logits), 0.0)
        between = lax.cumsum(log_fail, axis=3, reverse=True) - log_fail
        w = jnp.where(mask, jnp.exp(jax.nn.log_sigmoid(logits) + between), 0.0)
        outs.append(jnp.einsum('bhqk,bkhd->bqhd', w.astype(v.dtype), v[:, :kend]))
    return jnp.concatenate(outs, axis=1)


def hybrid_layer(x, norm_pre, w_in, b_gate, conv_w, conv_b, dt_bias, a_log, d_skip,
                 ssd_norm, w_ssd_proj, w_sb_proj, w_out, norm_post):
    bsz, L, _ = x.shape
    h = rmsnorm(x, norm_pre)
    proj = jnp.einsum('bld,de->ble', h, w_in)
    z_ssd, xbc, dt_raw, q, k, v, z_sb, gates = jnp.split(proj, _split_points(), axis=-1)

    xbc = lax.conv_general_dilated(
        xbc, conv_w[:, None, :], window_strides=(1,), padding=[(SSD_CONV - 1, 0)],
        dimension_numbers=('NWC', 'WIO', 'NWC'), feature_group_count=CONV_DIM) + conv_b
    xbc = jax.nn.silu(xbc)
    xs, bm, cm = jnp.split(xbc, [SSD_INNER, SSD_INNER + SSD_GROUPS * SSD_STATE], axis=-1)
    dt = jax.nn.softplus(dt_raw.astype(jnp.float32) + dt_bias.astype(jnp.float32))
    a = -jnp.exp(a_log.astype(jnp.float32))
    y = ssd_scan(xs.reshape(bsz, L, SSD_HEADS, SSD_HEAD_DIM).astype(jnp.float32), dt, a,
                 bm.reshape(bsz, L, SSD_GROUPS, SSD_STATE).astype(jnp.float32),
                 cm.reshape(bsz, L, SSD_GROUPS, SSD_STATE).astype(jnp.float32),
                 d_skip.astype(jnp.float32))
    y = y.reshape(bsz, L, SSD_INNER).astype(x.dtype)
    y = gated_group_rmsnorm(y, z_ssd, ssd_norm, SSD_GROUPS)
    y_ssd = jnp.einsum('ble,ed->bld', y, w_ssd_proj)

    o = stick_breaking(q.reshape(bsz, L, SB_HEADS, SB_HEAD_DIM),
                       k.reshape(bsz, L, SB_HEADS, SB_HEAD_DIM),
                       v.reshape(bsz, L, SB_HEADS, SB_HEAD_DIM)).reshape(bsz, L, SB_INNER)
    y_sb = jnp.einsum('ble,ed->bld', o * jax.nn.silu(z_sb), w_sb_proj)

    g = jax.nn.sigmoid(gates + b_gate)
    g_ssd, g_sb = jnp.split(g, [D_MODEL], axis=-1)
    merged = g_ssd * y_ssd + g_sb * y_sb
    out = jnp.einsum('bld,de->ble', merged, w_out)
    return x + rmsnorm(out, norm_post)


def setup_inputs(seed: int = 0) -> dict:
    key = jax.random.key(seed)
    ks = jax.random.split(key, 16)
    f32 = jnp.float32
    x = jax.random.normal(ks[0], (BATCH, SEQ, D_MODEL), f32)
    norm_pre = 1.0 + 0.05 * jax.random.normal(ks[1], (DEPTH, D_MODEL), f32)
    w_in = jax.random.normal(ks[2], (DEPTH, D_MODEL, IN_COLS), f32) * D_MODEL ** -0.5
    b_gate = 0.02 * jax.random.normal(ks[3], (DEPTH, N_BRANCH * D_MODEL), f32)
    conv_w = jax.random.normal(ks[4], (DEPTH, SSD_CONV, CONV_DIM), f32) * SSD_CONV ** -0.5
    conv_b = 0.02 * jax.random.normal(ks[5], (DEPTH, CONV_DIM), f32)
    u = jax.random.uniform(ks[6], (DEPTH, SSD_HEADS), f32)
    dt0 = jnp.exp(u * (math.log(0.1) - math.log(0.001)) + math.log(0.001))
    dt_bias = dt0 + jnp.log(-jnp.expm1(-dt0))
    a_log = jnp.log(jax.random.uniform(ks[7], (DEPTH, SSD_HEADS), f32, 1.0, 16.0))
    d_skip = 1.0 + 0.05 * jax.random.normal(ks[8], (DEPTH, SSD_HEADS), f32)
    ssd_norm = 1.0 + 0.05 * jax.random.normal(ks[9], (DEPTH, SSD_INNER), f32)
    w_ssd_proj = jax.random.normal(ks[10], (DEPTH, SSD_INNER, D_MODEL), f32) * SSD_INNER ** -0.5
    w_sb_proj = jax.random.normal(ks[11], (DEPTH, SB_INNER, D_MODEL), f32) * SB_INNER ** -0.5
    w_out = jax.random.normal(ks[12], (DEPTH, D_MODEL, D_MODEL), f32) * D_MODEL ** -0.5
    norm_post = 1.0 + 0.05 * jax.random.normal(ks[13], (DEPTH, D_MODEL), f32)
    return {"x": x, "norm_pre": norm_pre, "w_in": w_in, "b_gate": b_gate,
            "conv_w": conv_w, "conv_b": conv_b, "dt_bias": dt_bias, "a_log": a_log,
            "d_skip": d_skip, "ssd_norm": ssd_norm, "w_ssd_proj": w_ssd_proj,
            "w_sb_proj": w_sb_proj, "w_out": w_out, "norm_post": norm_post}


def reference(x, norm_pre, w_in, b_gate, conv_w, conv_b, dt_bias, a_log, d_skip,
              ssd_norm, w_ssd_proj, w_sb_proj, w_out, norm_post):
    for layer in range(DEPTH):
        x = hybrid_layer(x, norm_pre[layer], w_in[layer], b_gate[layer], conv_w[layer],
                         conv_b[layer], dt_bias[layer], a_log[layer], d_skip[layer],
                         ssd_norm[layer], w_ssd_proj[layer], w_sb_proj[layer],
                         w_out[layer], norm_post[layer])
    return x
```

```cpp
#include <hip/hip_runtime.h>
#include <cstdio>
#include <cstdint>

constexpr int DM = 1024, BATCH = 8, SEQ = 2048, NCOL = 8720;
constexpr int O_ZSSD = 0, O_XBC = 1024, O_DT = 2560, O_Q = 2576, O_K = 3600, O_V = 4624, O_ZSB = 5648, O_G = 6672;
constexpr int CONVD = 1536, NH = 16, HP = 64, NS = 128;
constexpr float EPS = 1e-6f;

__device__ __forceinline__ float block_sum(float v, float* red) {
#pragma unroll
    for (int o = 32; o > 0; o >>= 1) v += __shfl_xor(v, o);
    const int w = threadIdx.x >> 6;
    __syncthreads();
    if ((threadIdx.x & 63) == 0) red[w] = v;
    __syncthreads();
    return red[0] + red[1] + red[2] + red[3];
}
__device__ __forceinline__ float silu_f(float v) { return v / (1.f + expf(-v)); }
__device__ __forceinline__ float sigmoid_f(float v) { return 1.f / (1.f + expf(-v)); }

__global__ void __launch_bounds__(256) k_rmsnorm(const float* __restrict__ x, const float* __restrict__ w, const float* __restrict__ res, float* __restrict__ out) {
    __shared__ float red[4];
    const size_t r = blockIdx.x; const float* xr = x + r * DM;
    float v[4]; float s = 0.f;
#pragma unroll
    for (int i = 0; i < 4; ++i) { v[i] = xr[threadIdx.x + 256 * i]; s += v[i] * v[i]; }
    s = block_sum(s, red);
    const float rs = rsqrtf(s * (1.f / DM) + EPS);
#pragma unroll
    for (int i = 0; i < 4; ++i) { const int c = threadIdx.x + 256 * i; float o = v[i] * rs * w[c]; if (res) o += res[r * DM + c]; out[r * DM + c] = o; }
}

__global__ void __launch_bounds__(256) k_gemm(const float* __restrict__ A, int lda, const float* __restrict__ B, int ldb, float* __restrict__ C, int ldc, int M, int N, int K) {
    __shared__ float As[16][65];
    __shared__ float Bs[16][65];
    const int tx = threadIdx.x & 15, ty = threadIdx.x >> 4;
    const int m0 = blockIdx.y * 64, n0 = blockIdx.x * 64;
    float acc[4][4];
#pragma unroll
    for (int i = 0; i < 4; ++i)
#pragma unroll
        for (int j = 0; j < 4; ++j) acc[i][j] = 0.f;
    for (int k0 = 0; k0 < K; k0 += 16) {
#pragma unroll
        for (int i = 0; i < 4; ++i) { const int idx = threadIdx.x + 256 * i; const int r = idx >> 4, c = idx & 15; As[c][r] = A[(size_t)(m0 + r) * lda + k0 + c]; }
#pragma unroll
        for (int i = 0; i < 4; ++i) { const int idx = threadIdx.x + 256 * i; const int r = idx >> 6, c = idx & 63; Bs[r][c] = (n0 + c < N) ? B[(size_t)(k0 + r) * ldb + n0 + c] : 0.f; }
        __syncthreads();
#pragma unroll
        for (int kk = 0; kk < 16; ++kk) {
            float a[4], b[4];
#pragma unroll
            for (int i = 0; i < 4; ++i) { a[i] = As[kk][ty * 4 + i]; b[i] = Bs[kk][tx * 4 + i]; }
#pragma unroll
            for (int i = 0; i < 4; ++i)
#pragma unroll
                for (int j = 0; j < 4; ++j) acc[i][j] += a[i] * b[j];
        }
        __syncthreads();
    }
#pragma unroll
    for (int i = 0; i < 4; ++i)
#pragma unroll
        for (int j = 0; j < 4; ++j) { const int n = n0 + tx * 4 + j; if (n < N) C[(size_t)(m0 + ty * 4 + i) * ldc + n] = acc[i][j]; }
}

__global__ void __launch_bounds__(256) k_conv(const float* __restrict__ proj, const float* __restrict__ cw, const float* __restrict__ cb, float* __restrict__ xc) {
    const int idx = blockIdx.x * 256 + threadIdx.x; const int t = idx / CONVD, c = idx % CONVD;
    float s = cb[c];
#pragma unroll
    for (int j = 0; j < 4; ++j) { const int tt = t - 3 + j; if (tt >= 0) s += cw[j * CONVD + c] * proj[(size_t)tt * NCOL + O_XBC + c]; }
    xc[idx] = silu_f(s);
}

__global__ void __launch_bounds__(256) k_ssd(const float* __restrict__ proj, const float* __restrict__ xc, const float* __restrict__ dt_bias, const float* __restrict__ a_log, const float* __restrict__ d_skip, float* __restrict__ y) {
    const int h = blockIdx.x, g = h >> 3, p = threadIdx.x >> 2, nq = threadIdx.x & 3;
    const float a = -expf(a_log[h]), dsk = d_skip[h], dtb = dt_bias[h];
    float st[32];
#pragma unroll
    for (int i = 0; i < 32; ++i) st[i] = 0.f;
    for (int t = 0; t < SEQ; ++t) {
        const float raw = proj[(size_t)t * NCOL + O_DT + h] + dtb;
        const float dt = raw > 20.f ? raw : log1pf(expf(raw));
        const float dec = expf(dt * a);
        const float xv = xc[(size_t)t * CONVD + h * HP + p];
        const float xdt = xv * dt;
        const float* Bp = xc + (size_t)t * CONVD + 1024 + g * NS + nq * 32;
        const float* Cp = xc + (size_t)t * CONVD + 1024 + 256 + g * NS + nq * 32;
        float acc = 0.f;
#pragma unroll
        for (int i = 0; i < 32; ++i) { st[i] = st[i] * dec + xdt * Bp[i]; acc += Cp[i] * st[i]; }
        acc += __shfl_xor(acc, 1); acc += __shfl_xor(acc, 2);
        if (nq == 0) y[(size_t)t * DM + h * HP + p] = acc + xv * dsk;
    }
}

__global__ void __launch_bounds__(256) k_gnorm(const float* __restrict__ y, const float* __restrict__ proj, const float* __restrict__ w, float* __restrict__ out) {
    __shared__ float red[4];
    const size_t t = blockIdx.x;
    float gv[4]; float s0 = 0.f, s1 = 0.f;
#pragma unroll
    for (int i = 0; i < 4; ++i) { const int c = threadIdx.x + 256 * i; gv[i] = y[t * DM + c] * silu_f(proj[t * NCOL + O_ZSSD + c]); if (i < 2) s0 += gv[i] * gv[i]; else s1 += gv[i] * gv[i]; }
    s0 = block_sum(s0, red); s1 = block_sum(s1, red);
    const float r0 = rsqrtf(s0 * (1.f / 512.f) + EPS), r1 = rsqrtf(s1 * (1.f / 512.f) + EPS);
#pragma unroll
    for (int i = 0; i < 4; ++i) { const int c = threadIdx.x + 256 * i; out[t * DM + c] = gv[i] * (i < 2 ? r0 : r1) * w[c]; }
}

__global__ void __launch_bounds__(256) k_attn(const float* __restrict__ proj, float* __restrict__ og) {
    __shared__ float Ks[64][64];
    __shared__ float Vs[64][64];
    const int h = blockIdx.y, t = blockIdx.x * 256 + threadIdx.x;
    float q[64], o[64];
#pragma unroll
    for (int d = 0; d < 64; ++d) { q[d] = proj[(size_t)t * NCOL + O_Q + h * 64 + d] * 0.125f; o[d] = 0.f; }
    float F = 1.f;
    for (int kt = blockIdx.x * 4 + 3; kt >= 0; --kt) {
        __syncthreads();
#pragma unroll
        for (int i = 0; i < 16; ++i) { const int idx = threadIdx.x + 256 * i; const int r = idx >> 6, c = idx & 63;
            Ks[r][c] = proj[(size_t)(kt * 64 + r) * NCOL + O_K + h * 64 + c]; Vs[r][c] = proj[(size_t)(kt * 64 + r) * NCOL + O_V + h * 64 + c]; }
        __syncthreads();
        for (int s = 63; s >= 0; --s) {
            const int ks = kt * 64 + s;
            if (ks < t && F > 0.f) {
                float z = 0.f;
#pragma unroll
                for (int d = 0; d < 64; ++d) z += q[d] * Ks[s][d];
                const float e = expf(fminf(z, 80.f)), r = 1.f / (1.f + e);
                const float wgt = e * r * F; F *= r;
#pragma unroll
                for (int d = 0; d < 64; ++d) o[d] += wgt * Vs[s][d];
            }
        }
    }
#pragma unroll
    for (int d = 0; d < 64; ++d) og[(size_t)t * DM + h * 64 + d] = o[d] * silu_f(proj[(size_t)t * NCOL + O_ZSB + h * 64 + d]);
}

__global__ void __launch_bounds__(256) k_merge(const float* __restrict__ proj, const float* __restrict__ bg, const float* __restrict__ ys, const float* __restrict__ yb, float* __restrict__ mg) {
    const int idx = blockIdx.x * 256 + threadIdx.x; const int t = idx >> 10, d = idx & 1023;
    const float g1 = sigmoid_f(proj[(size_t)t * NCOL + O_G + d] + bg[d]), g2 = sigmoid_f(proj[(size_t)t * NCOL + O_G + 1024 + d] + bg[1024 + d]);
    mg[idx] = g1 * ys[idx] + g2 * yb[idx];
}

extern "C" void kernel_launch(void* const* d_in, const int* in_sizes, int n_in, void* d_out, int out_size, void* d_ws, size_t ws_size, hipStream_t stream) {
    const float* x = (const float*)d_in[0]; const float* norm_pre = (const float*)d_in[1]; const float* w_in = (const float*)d_in[2]; const float* b_gate = (const float*)d_in[3];
    const float* conv_w = (const float*)d_in[4]; const float* conv_b = (const float*)d_in[5]; const float* dt_bias = (const float*)d_in[6]; const float* a_log = (const float*)d_in[7];
    const float* d_skip = (const float*)d_in[8]; const float* ssd_norm = (const float*)d_in[9]; const float* w_ssd = (const float*)d_in[10]; const float* w_sb = (const float*)d_in[11];
    const float* w_out = (const float*)d_in[12]; const float* norm_post = (const float*)d_in[13];
    float* out = (float*)d_out;
    static bool once = false;
    if (!once) { once = true; fprintf(stderr, "kernel_launch: n_in %d out_size %d ws_size %zu\n", n_in, out_size, ws_size); }
    float* ws = (float*)d_ws;
    float* proj = ws;
    float* hbuf = proj + (size_t)SEQ * NCOL;
    float* xc = hbuf + (size_t)SEQ * DM;
    float* ybuf = xc + (size_t)SEQ * CONVD;
    float* yn = ybuf + (size_t)SEQ * DM;
    float* og = yn + (size_t)SEQ * DM;
    float* ys = og + (size_t)SEQ * DM;
    float* yb = ys + (size_t)SEQ * DM;
    float* mg = yb + (size_t)SEQ * DM;
    float* ob = mg + (size_t)SEQ * DM;
    for (int b = 0; b < BATCH; ++b) {
        const float* xb = x + (size_t)b * SEQ * DM; float* outb = out + (size_t)b * SEQ * DM;
        k_rmsnorm<<<SEQ, 256, 0, stream>>>(xb, norm_pre, nullptr, hbuf);
        k_gemm<<<dim3((NCOL + 63) / 64, SEQ / 64), 256, 0, stream>>>(hbuf, DM, w_in, NCOL, proj, NCOL, SEQ, NCOL, DM);
        k_conv<<<SEQ * CONVD / 256, 256, 0, stream>>>(proj, conv_w, conv_b, xc);
        k_ssd<<<NH, 256, 0, stream>>>(proj, xc, dt_bias, a_log, d_skip, ybuf);
        k_gnorm<<<SEQ, 256, 0, stream>>>(ybuf, proj, ssd_norm, yn);
        k_attn<<<dim3(SEQ / 256, NH), 256, 0, stream>>>(proj, og);
        k_gemm<<<dim3(DM / 64, SEQ / 64), 256, 0, stream>>>(yn, DM, w_ssd, DM, ys, DM, SEQ, DM, DM);
        k_gemm<<<dim3(DM / 64, SEQ / 64), 256, 0, stream>>>(og, DM, w_sb, DM, yb, DM, SEQ, DM, DM);
        k_merge<<<SEQ * DM / 256, 256, 0, stream>>>(proj, b_gate, ys, yb, mg);
        k_gemm<<<dim3(DM / 64, SEQ / 64), 256, 0, stream>>>(mg, DM, w_out, DM, ob, DM, SEQ, DM, DM);
        k_rmsnorm<<<SEQ, 256, 0, stream>>>(ob, norm_post, xb, outb);
    }
}
```

```cpp
#include <hip/hip_runtime.h>
#include <cstdio>
#include <cstdint>

#define GAS __attribute__((address_space(1)))
#define LAS __attribute__((address_space(3)))
#define DI __device__ __forceinline__
typedef unsigned short bf16;
typedef unsigned v4u __attribute__((ext_vector_type(4)));
typedef unsigned u32x2 __attribute__((ext_vector_type(2)));
typedef float f32x4 __attribute__((ext_vector_type(4)));
typedef float f32x2 __attribute__((ext_vector_type(2)));
typedef float f32x16 __attribute__((ext_vector_type(16)));
typedef short bf16x8 __attribute__((ext_vector_type(8)));
typedef short s16x4 __attribute__((ext_vector_type(4)));
typedef __bf16 bf16x2_t __attribute__((ext_vector_type(2)));
typedef GAS unsigned gu32;
typedef GAS unsigned long long gu64;
#define RLX_AGENT __ATOMIC_RELAXED, __HIP_MEMORY_SCOPE_AGENT
#define LDS_WAIT() asm volatile("s_waitcnt lgkmcnt(0)" ::: "memory")
#define VM_WAIT() asm volatile("s_waitcnt vmcnt(0)" ::: "memory")
DI unsigned f2bf(float f) { unsigned u = __builtin_bit_cast(unsigned, f); return (u + 0x7fffu + ((u >> 16) & 1u)) >> 16; }
DI unsigned pk2(float lo, float hi) { return f2bf(lo) | (f2bf(hi) << 16); }
DI unsigned cvtpk(float lo, float hi) { f32x2 v = {lo, hi}; bf16x2_t b = __builtin_convertvector(v, bf16x2_t); return __builtin_bit_cast(unsigned, b); }
DI float bflo(unsigned w) { return __uint_as_float(w << 16); }
DI float bfhi(unsigned w) { return __uint_as_float(w & 0xffff0000u); }
DI float bf2f(unsigned short u) { return __uint_as_float((unsigned)u << 16); }
constexpr float LOG2E = 1.4426950408889634f;
DI float fexp2(float x) { return __builtin_amdgcn_exp2f(x); }
DI float frcp(float x) { return __builtin_amdgcn_rcpf(x); }
DI float silu_f(float v) { return v * frcp(1.f + fexp2(-v * LOG2E)); }
DI float sigm_f(float v) { return frcp(1.f + fexp2(-v * LOG2E)); }
#define MFMA32(a, b, c) __builtin_amdgcn_mfma_f32_32x32x16_bf16((a), (b), (c), 0, 0, 0)

constexpr int BATCH = 8, SEQ = 2048, DMODEL = 1024, M = BATCH * SEQ;
constexpr int NH = 16, HP = 64, NS = 128, CONVD = 1536, CHUNK = 64;
constexpr int NPROJ = 6912;
constexpr float EPS = 1e-6f;
constexpr float QSCALE = 0.125f * LOG2E;

namespace pg8 {
#define PG8_LAS __attribute__((address_space(3)))
typedef unsigned short bf16_t;
typedef short bf16x8 __attribute__((ext_vector_type(8)));
typedef float f32x4 __attribute__((ext_vector_type(4)));
typedef unsigned u32x4 __attribute__((ext_vector_type(4)));
constexpr int BM = 256, BK = 64, HALF = 128, HTB = HALF * BK * 2  , STAGE_BYTES = 8 * HTB, NXCD = 8, WGM = 8;

__host__ __device__ __forceinline__ int lds_byte(int r, int c) { const int st = (r >> 4) * 2 + (c >> 5), rr = r & 15, cc = c & 31, ob = rr * 64 + cc * 2; return st * 1024 + (ob ^ (((ob >> 9) & 1) << 5)); }
__host__ __device__ __forceinline__ void stage_rc(int b, int& R, int& C) { const int st = b / 1024, sb = b % 1024, swz = sb ^ (((sb >> 9) & 1) << 5); R = (st >> 1) * 16 + swz / 64; C = (st & 1) * 32 + (swz % 64) / 2; }
__host__ __device__ __forceinline__ int perm32(int rho) { const int n = rho >> 4, i = rho & 15; return 8 * (i >> 2) + 4 * n + (i & 3); }

struct Unit { int pm, pn, kind; };
struct Gemm { const bf16_t* A[4]; const bf16_t* Bt[4]; int K; };
__device__ __forceinline__ const char* a_base(const Gemm& g, int k) { return (const char*)(k == 0 ? g.A[0] : (k == 1 ? g.A[1] : (k == 2 ? g.A[2] : g.A[3]))); }
__device__ __forceinline__ const char* b_base(const Gemm& g, int k) { return (const char*)(k == 0 ? g.Bt[0] : (k == 1 ? g.Bt[1] : (k == 2 ? g.Bt[2] : g.Bt[3]))); }

struct StaticOrder {
    int nM, nN, nwg, G, c;
    __host__ __device__ void init(int M_, int N_, int G_, int c_) { nM = M_ / BM; nN = N_ / BM; nwg = nM * nN; G = G_; c = c_; }
    __host__ __device__ bool next(int i, Unit& u) const {
        const long L = (long)i * G + c; if (L >= nwg) return false;
        int wgid = (int)L; { const int q = nwg / NXCD, r = nwg % NXCD, xcd = wgid % NXCD, off = wgid / NXCD; wgid = (xcd < r ? xcd * (q + 1) : r * (q + 1) + (xcd - r) * q) + off; }
        const int nig = WGM * nN, gid = wgid / nig, fm = gid * WGM, gsz = (nM - fm) < WGM ? (nM - fm) : WGM;
        u.pm = fm + ((wgid % nig) % gsz); u.pn = (wgid % nig) / gsz; u.kind = 0; return true;
    }
    __device__ __forceinline__ void a_ready(const Unit&) const {}
    __device__ __forceinline__ void done(const Unit&) const {}
};
struct QuadOrder {
    StaticOrder so;
    __device__ void init(int M_, int N_, int G_, int c_) { so.init(M_, N_, G_, c_); }
    __device__ bool next(int i, Unit& u) const { if (!so.next(i >> 2, u)) return false; u.kind = i & 3; return true; }
    __device__ __forceinline__ void a_ready(const Unit&) const {}
    __device__ __forceinline__ void done(const Unit&) const {}
};
__device__ __forceinline__ unsigned cvt_pk_bf16(float lo, float hi) { unsigned r; asm volatile("v_cvt_pk_bf16_f32 %0, %1, %2" : "=v"(r) : "v"(lo), "v"(hi)); return r; }

__device__ __forceinline__ float silu1(float v) { return v * __builtin_amdgcn_rcpf(1.f + __builtin_amdgcn_exp2f(-v * 1.4426950408889634f)); }
__device__ __forceinline__ float sigm1(float v) { return __builtin_amdgcn_rcpf(1.f + __builtin_amdgcn_exp2f(-v * 1.4426950408889634f)); }
__device__ __forceinline__ float bl(unsigned w) { return __uint_as_float(w << 16); }
__device__ __forceinline__ float bh(unsigned w) { return __uint_as_float(w & 0xffff0000u); }

struct EpiProj {
    static constexpr bool PERM = true, AFTER_DRAIN = false, MIDK = false;
    bf16_t *ZS, *XBC, *Q, *K, *V, *ZB; float* DT; const float* dt_bias; float qscale;
    __device__ __forceinline__ void midk(f32x4 (&)[2][2][4][2], const Unit&, int, int, int, int) const {}
    __device__ __forceinline__ void operator()(const f32x4 (&acc)[2][2][4][2], const Unit& u, int wr, int wc, int fr, int fq) const {
        const int pn = u.pn; const int row0 = u.pm * BM + wr * 64 + fr;
        if (pn == 26) {
            if (wc == 0 && fq < 2) {
#pragma unroll
                for (int ai = 0; ai < 2; ++ai)
#pragma unroll
                    for (int m = 0; m < 4; ++m) { float* rp = DT + (size_t)(row0 + ai * HALF + m * 16) * 16 + 8 * fq;
#pragma unroll
                        for (int n = 0; n < 2; ++n) { f32x4 o;
#pragma unroll
                            for (int e = 0; e < 4; ++e) { const float raw = acc[ai][0][m][n][e] + dt_bias[8 * fq + 4 * n + e]; o[e] = raw > 20.f ? raw : log1pf(expf(raw)); }
                            *(f32x4*)(rp + 4 * n) = o; } }
            }
            return;
        }
        bf16_t* base; int ldc, colt; bool act = false; float sc = 1.f;
        if (pn < 4) { base = ZS; ldc = 1024; colt = pn * 256; act = true; }
        else if (pn < 10) { base = XBC; ldc = 1536; colt = (pn - 4) * 256; }
        else if (pn < 14) { base = Q; ldc = 1024; colt = (pn - 10) * 256; sc = qscale; }
        else if (pn < 18) { base = K; ldc = 1024; colt = (pn - 14) * 256; }
        else if (pn < 22) { base = V; ldc = 1024; colt = (pn - 18) * 256; }
        else { base = ZB; ldc = 1024; colt = (pn - 22) * 256; act = true; }
        const int col0 = colt + wc * 32 + 8 * fq;
#pragma unroll
        for (int ai = 0; ai < 2; ++ai)
#pragma unroll
            for (int m = 0; m < 4; ++m) { bf16_t* rowp = base + (size_t)(row0 + ai * HALF + m * 16) * ldc + col0;
#pragma unroll
                for (int bj = 0; bj < 2; ++bj) { f32x4 v0 = acc[ai][bj][m][0], v1 = acc[ai][bj][m][1];
                    if (act) {
#pragma unroll
                        for (int e = 0; e < 4; ++e) { v0[e] = silu1(v0[e]); v1[e] = silu1(v1[e]); } }
                    v0 = v0 * sc; v1 = v1 * sc; u32x4 w; w.x = cvt_pk_bf16(v0[0], v0[1]); w.y = cvt_pk_bf16(v0[2], v0[3]); w.z = cvt_pk_bf16(v1[0], v1[1]); w.w = cvt_pk_bf16(v1[2], v1[3]);
                    *(u32x4*)(rowp + bj * HALF) = w; } }
    }
};

struct EpiMerge {
    static constexpr bool PERM = true, AFTER_DRAIN = false, MIDK = true;
    bf16_t *MG1, *MG2; const float* bg; const PG8_LAS float* rowfac;
    __device__ __forceinline__ void midk(f32x4 (&acc)[2][2][4][2], const Unit& u, int wr, int wc, int fr, int fq) const {
        if (u.kind != 1) return;
#pragma unroll
        for (int ai = 0; ai < 2; ++ai)
#pragma unroll
            for (int m = 0; m < 4; ++m) { const float f = rowfac[(ai * HALF + wr * 64 + m * 16 + fr) * 2];
#pragma unroll
                for (int bj = 0; bj < 2; ++bj)
#pragma unroll
                    for (int n = 0; n < 2; ++n) acc[ai][bj][m][n] = acc[ai][bj][m][n] * f; }
    }
    __device__ __forceinline__ void operator()(const f32x4 (&acc)[2][2][4][2], const Unit& u, int wr, int wc, int fr, int fq) const {
        const int kind = u.kind; const int row0 = u.pm * BM + wr * 64 + fr, col0 = u.pn * BM + wc * 32 + 8 * fq;
        f32x4 bv[2][2];
#pragma unroll
        for (int bj = 0; bj < 2; ++bj)
#pragma unroll
            for (int n = 0; n < 2; ++n) bv[bj][n] = (kind == 0 || kind == 2) ? *(const f32x4*)(bg + (kind == 2 ? 1024 : 0) + col0 + bj * HALF + 4 * n) : (f32x4){0.f, 0.f, 0.f, 0.f};
#pragma unroll
        for (int ai = 0; ai < 2; ++ai)
#pragma unroll
            for (int m = 0; m < 4; ++m) { const int rl = ai * HALF + wr * 64 + m * 16 + fr; const size_t off = (size_t)(row0 + ai * HALF + m * 16) * 1024 + col0;
                const float rs1 = (kind == 1) ? rowfac[rl * 2 + 1] : 1.f;
#pragma unroll
                for (int bj = 0; bj < 2; ++bj) { f32x4 v0 = acc[ai][bj][m][0], v1 = acc[ai][bj][m][1]; bf16_t* dst;
                    if (kind == 0 || kind == 2) {
#pragma unroll
                        for (int e = 0; e < 4; ++e) { v0[e] = sigm1(v0[e] + bv[bj][0][e]); v1[e] = sigm1(v1[e] + bv[bj][1][e]); }
                        dst = (kind == 0 ? MG1 : MG2) + off + bj * HALF;
                    } else if (kind == 1) {
                        const u32x4 g = *(const u32x4*)(MG1 + off + bj * HALF);
                        v0[0] *= rs1 * bl(g.x); v0[1] *= rs1 * bh(g.x); v0[2] *= rs1 * bl(g.y); v0[3] *= rs1 * bh(g.y);
                        v1[0] *= rs1 * bl(g.z); v1[1] *= rs1 * bh(g.z); v1[2] *= rs1 * bl(g.w); v1[3] *= rs1 * bh(g.w);
                        dst = MG1 + off + bj * HALF;
                    } else {
                        const u32x4 a = *(const u32x4*)(MG1 + off + bj * HALF); const u32x4 g = *(const u32x4*)(MG2 + off + bj * HALF);
                        v0[0] = bl(a.x) + bl(g.x) * v0[0]; v0[1] = bh(a.x) + bh(g.x) * v0[1]; v0[2] = bl(a.y) + bl(g.y) * v0[2]; v0[3] = bh(a.y) + bh(g.y) * v0[3];
                        v1[0] = bl(a.z) + bl(g.z) * v1[0]; v1[1] = bh(a.z) + bh(g.z) * v1[1]; v1[2] = bl(a.w) + bl(g.w) * v1[2]; v1[3] = bh(a.w) + bh(g.w) * v1[3];
                        dst = MG2 + off + bj * HALF;
                    }
                    u32x4 w; w.x = cvt_pk_bf16(v0[0], v0[1]); w.y = cvt_pk_bf16(v0[2], v0[3]); w.z = cvt_pk_bf16(v1[0], v1[1]); w.w = cvt_pk_bf16(v1[2], v1[3]);
                    *(u32x4*)dst = w; } }
    }
};

struct EpiF32 {
    static constexpr bool PERM = false, AFTER_DRAIN = false, MIDK = false;
    float* out; int ldc;
    __device__ __forceinline__ void midk(f32x4 (&)[2][2][4][2], const Unit&, int, int, int, int) const {}
    __device__ __forceinline__ void operator()(const f32x4 (&acc)[2][2][4][2], const Unit& u, int wr, int wc, int fr, int fq) const {
        const int row0 = u.pm * BM + wr * 64 + fr, col0 = u.pn * BM + wc * 32 + 4 * fq;
#pragma unroll
        for (int ai = 0; ai < 2; ++ai)
#pragma unroll
            for (int m = 0; m < 4; ++m) { float* rowp = out + (size_t)(row0 + ai * HALF + m * 16) * ldc + col0;
#pragma unroll
                for (int bj = 0; bj < 2; ++bj)
#pragma unroll
                    for (int n = 0; n < 2; ++n) *(f32x4*)(rowp + bj * HALF + n * 16) = acc[ai][bj][m][n]; }
    }
};

template <class Epi, class Sched, bool ALIGN_EPI = false, bool SP2 = false>
__device__ __forceinline__ void gemm_phase(PG8_LAS unsigned char* lds, const Gemm g, const Sched& S, const Epi& E) {
    const int tid = threadIdx.x, wid = __builtin_amdgcn_readfirstlane(tid >> 6), lane = tid & 63, wr = wid >> 2, wc = wid & 3, fr = lane & 15, fq = lane >> 4;
    const int K = g.K, nt = K / BK;
    unsigned voffA[2], voffB[2];
#pragma unroll
    for (int i = 0; i < 2; ++i) { int R, C; stage_rc(tid * 16 + i * 8192, R, C); const int Rb = Epi::PERM ? ((R & ~31) + perm32(R & 31)) : R;
        voffA[i] = (unsigned)(R * K + C) * 2u; voffB[i] = (unsigned)(Rb * K + C) * 2u; }
    const size_t kstep = (size_t)(BK * 2);
    const size_t hstep = (size_t)HALF * K * 2;
    const size_t tstep = 2 * hstep;
    const unsigned ldsw = (unsigned)wid * 1024u;
    const int aoff = lds_byte(wr * 64 + fr, fq * 8), boff = lds_byte(wc * 32 + fr, fq * 8);
#define PG8_SA(b, h) (((b) * 2 + (h)) * HTB)
#define PG8_SB(b, h) ((4 + (b) * 2 + (h)) * HTB)
#define PG8_STAGE(bufoff, gbase, voff) do { _Pragma("unroll") for (int _i = 0; _i < 2; ++_i) \
        __builtin_amdgcn_global_load_lds((const unsigned*)((const char*)(gbase) + (voff)[_i]), (PG8_LAS unsigned*)(lds + (bufoff) + ldsw + _i * 8192), 16, 0, 0); } while (0)
#define PG8_LDA(dst, b, h) do { _Pragma("unroll") for (int m = 0; m < 4; ++m) _Pragma("unroll") for (int k = 0; k < 2; ++k) dst[m][k] = *(const PG8_LAS bf16x8*)(lds + PG8_SA(b, h) + aoff + m * 2048 + k * 1024); } while (0)
#define PG8_LDB(dst, b, h) do { _Pragma("unroll") for (int n = 0; n < 2; ++n) _Pragma("unroll") for (int k = 0; k < 2; ++k) dst[n][k] = *(const PG8_LAS bf16x8*)(lds + PG8_SB(b, h) + boff + n * 2048 + k * 1024); } while (0)
#define PG8_MMA(ai, bj, At, Bt) do { __builtin_amdgcn_s_setprio(1); _Pragma("unroll") for (int m = 0; m < 4; ++m) _Pragma("unroll") for (int n = 0; n < 2; ++n) _Pragma("unroll") for (int k = 0; k < 2; ++k) \
        acc[ai][bj][m][n] = __builtin_amdgcn_mfma_f32_16x16x32_bf16(Bt[n][k], At[m][k], acc[ai][bj][m][n], 0, 0, 0); __builtin_amdgcn_s_setprio(0); } while (0)
#define PG8_WAIT_V(n) asm volatile("s_waitcnt vmcnt(" #n ")" ::: "memory")
#define PG8_WAIT_L(n) asm volatile("s_waitcnt lgkmcnt(" #n ")" ::: "memory")
#define PG8_BAR __builtin_amdgcn_s_barrier()
#define PG8_SCHED __builtin_amdgcn_sched_barrier(0)
    Unit cur, nxt; int ui = 0;
    if (!S.next(0, cur)) return;
    f32x4 acc[2][2][4][2];
#pragma unroll
    for (int a = 0; a < 2; ++a)
#pragma unroll
        for (int b = 0; b < 2; ++b)
#pragma unroll
            for (int m = 0; m < 4; ++m)
#pragma unroll
                for (int n = 0; n < 2; ++n) acc[a][b][m][n] = (f32x4){0.f, 0.f, 0.f, 0.f};
    bf16x8 At[4][2], B0[2][2], B1[2][2];
    const char* cA = a_base(g, cur.kind) + (size_t)cur.pm * tstep; const char* cB = b_base(g, cur.kind) + (size_t)cur.pn * tstep;
    S.a_ready(cur);
    if constexpr (SP2) {
        PG8_STAGE(PG8_SB(0, 0), cB, voffB); PG8_STAGE(PG8_SB(0, 1), cB + hstep, voffB); PG8_STAGE(PG8_SA(0, 0), cA, voffA); PG8_STAGE(PG8_SA(0, 1), cA + hstep, voffA);
        if (wr == 1) PG8_BAR;
        PG8_WAIT_V(2); PG8_BAR;
        PG8_STAGE(PG8_SB(1, 0), cB + kstep, voffB); PG8_STAGE(PG8_SA(1, 0), cA + kstep, voffA); PG8_STAGE(PG8_SB(1, 1), cB + hstep + kstep, voffB);
        PG8_WAIT_V(6); PG8_BAR;
    } else {
        PG8_STAGE(PG8_SB(0, 0), cB, voffB); PG8_STAGE(PG8_SA(0, 0), cA, voffA); PG8_STAGE(PG8_SB(0, 1), cB + hstep, voffB); PG8_STAGE(PG8_SA(0, 1), cA + hstep, voffA);
        if (wr == 1) PG8_BAR;
        PG8_WAIT_V(4); PG8_BAR;
        PG8_STAGE(PG8_SB(1, 0), cB + kstep, voffB); PG8_STAGE(PG8_SA(1, 0), cA + kstep, voffA); PG8_STAGE(PG8_SB(1, 1), cB + hstep + kstep, voffB);
        PG8_WAIT_V(6); PG8_BAR;
    }
    for (;;) {
        const bool has_next = S.next(ui + 1, nxt);
        const char* nA = has_next ? a_base(g, nxt.kind) + (size_t)nxt.pm * tstep : cA; const char* nB = has_next ? b_base(g, nxt.kind) + (size_t)nxt.pn * tstep : cB;
        for (int t = 0; t < nt; t += 2) {
            const bool last = (t == nt - 2);
            if constexpr (Epi::MIDK) { if (t == nt / 2) E.midk(acc, cur, wr, wc, fr, fq); }
            const char* a1 = cA + (size_t)(t + 1) * kstep;
            const char* a2 = last ? nA : cA + (size_t)(t + 2) * kstep; const char* b2 = last ? nB : cB + (size_t)(t + 2) * kstep;
            const char* a3 = a2 + kstep; const char* b3 = b2 + kstep;
            if (last && has_next) S.a_ready(nxt);
            if constexpr (SP2) {
            PG8_LDB(B0, 0, 0); PG8_LDB(B1, 0, 1); PG8_SCHED; PG8_LDA(At, 0, 0); PG8_STAGE(PG8_SA(1, 1), a1 + hstep, voffA);
            PG8_WAIT_V(8); PG8_WAIT_L(0); PG8_BAR; PG8_MMA(0, 0, At, B0); PG8_MMA(0, 1, At, B1); PG8_BAR; PG8_SCHED;
            PG8_LDA(At, 0, 1); PG8_STAGE(PG8_SB(0, 0), b2, voffB); PG8_STAGE(PG8_SB(0, 1), b2 + hstep, voffB); PG8_STAGE(PG8_SA(0, 0), a2, voffA);
            PG8_WAIT_V(8); PG8_WAIT_L(0); PG8_BAR; PG8_MMA(1, 0, At, B0); PG8_MMA(1, 1, At, B1); PG8_BAR; PG8_SCHED;
            PG8_LDB(B0, 1, 0); PG8_LDB(B1, 1, 1); PG8_SCHED; PG8_LDA(At, 1, 0); PG8_STAGE(PG8_SA(0, 1), a2 + hstep, voffA);
            PG8_WAIT_V(8); PG8_WAIT_L(0); PG8_BAR; PG8_MMA(0, 0, At, B0); PG8_MMA(0, 1, At, B1); PG8_BAR; PG8_SCHED;
            PG8_LDA(At, 1, 1); PG8_STAGE(PG8_SB(1, 0), b3, voffB); PG8_STAGE(PG8_SB(1, 1), b3 + hstep, voffB); PG8_STAGE(PG8_SA(1, 0), a3, voffA);
            PG8_WAIT_V(8); PG8_WAIT_L(0); PG8_BAR; PG8_MMA(1, 0, At, B0); PG8_MMA(1, 1, At, B1); PG8_BAR; PG8_SCHED;
            } else {
            PG8_LDB(B0, 0, 0); PG8_SCHED; PG8_LDA(At, 0, 0); PG8_STAGE(PG8_SA(1, 1), a1 + hstep, voffA);
            PG8_WAIT_L(8); PG8_BAR; PG8_WAIT_L(0); PG8_MMA(0, 0, At, B0); PG8_BAR; PG8_SCHED;
            PG8_LDB(B1, 0, 1); PG8_STAGE(PG8_SB(0, 0), b2, voffB);
            PG8_BAR; PG8_WAIT_L(0); PG8_MMA(0, 1, At, B1); PG8_BAR;
            PG8_LDA(At, 0, 1); PG8_STAGE(PG8_SA(0, 0), a2, voffA);
            PG8_BAR; PG8_WAIT_L(0); PG8_MMA(1, 0, At, B0); PG8_BAR; PG8_SCHED;
            PG8_STAGE(PG8_SB(0, 1), b2 + hstep, voffB);
            PG8_WAIT_V(6); PG8_BAR; PG8_MMA(1, 1, At, B1); PG8_BAR;
            PG8_LDB(B0, 1, 0); PG8_SCHED; PG8_LDA(At, 1, 0); PG8_STAGE(PG8_SA(0, 1), a2 + hstep, voffA);
            PG8_WAIT_L(8); PG8_BAR; PG8_WAIT_L(0); PG8_MMA(0, 0, At, B0); PG8_BAR; PG8_SCHED;
            PG8_LDB(B1, 1, 1); PG8_STAGE(PG8_SB(1, 0), b3, voffB);
            PG8_BAR; PG8_WAIT_L(0); PG8_MMA(0, 1, At, B1); PG8_BAR;
            PG8_LDA(At, 1, 1); PG8_STAGE(PG8_SA(1, 0), a3, voffA);
            PG8_BAR; PG8_WAIT_L(0); PG8_MMA(1, 0, At, B0); PG8_BAR; PG8_SCHED;
            PG8_STAGE(PG8_SB(1, 1), b3 + hstep, voffB);
            PG8_WAIT_V(6); PG8_BAR; PG8_MMA(1, 1, At, B1); PG8_BAR;
            }
        }
        if constexpr (ALIGN_EPI) { if (wr == 0) PG8_BAR; }
        if constexpr (!Epi::AFTER_DRAIN) { E(acc, cur, wr, wc, fr, fq); S.done(cur); }
        if (!has_next) break;
#pragma unroll
        for (int a = 0; a < 2; ++a)
#pragma unroll
            for (int b = 0; b < 2; ++b)
#pragma unroll
                for (int m = 0; m < 4; ++m)
#pragma unroll
                    for (int n = 0; n < 2; ++n) acc[a][b][m][n] = (f32x4){0.f, 0.f, 0.f, 0.f};
        cur = nxt; cA = nA; cB = nB; ++ui;
        if constexpr (ALIGN_EPI) { if (wr == 1) PG8_BAR; }
    }
    PG8_WAIT_V(0);
    if constexpr (!ALIGN_EPI) { if (wr == 0) PG8_BAR; }
    PG8_BAR;
    if constexpr (Epi::AFTER_DRAIN) { E.fused(acc, cur, wr, wc, fr, fq, lds, wid, lane); S.done(cur); }
#undef PG8_SA
#undef PG8_SB
#undef PG8_STAGE
#undef PG8_LDA
#undef PG8_LDB
#undef PG8_MMA
#undef PG8_WAIT_V
#undef PG8_WAIT_L
#undef PG8_BAR
#undef PG8_SCHED
}
}

#define XB_TMO      128
#define XB_XCNT(j)  (256  + 64 * (j))
#define XB_XSUB(j)  (1280 + 64 * (j))
#define XB_XGEN(j)  (2304 + 64 * (j))
#define XB_TOP      3328
#define XB_TOPGEN   3392
#define XCD_BAR_WORDS 3456
#define XB_SPIN_CAP (1u << 18)

__device__ __forceinline__ unsigned xb_ld(unsigned* p)              { return __hip_atomic_load(p, __ATOMIC_RELAXED, __HIP_MEMORY_SCOPE_AGENT); }
__device__ __forceinline__ unsigned xb_add(unsigned* p, unsigned v) { return __hip_atomic_fetch_add(p, v, __ATOMIC_RELAXED, __HIP_MEMORY_SCOPE_AGENT); }
__device__ __forceinline__ unsigned xb_xcc_id() { return (unsigned)__builtin_amdgcn_s_getreg((3 << 11) | 20) & 0xFu; }
#define XB_SPIN(cond, bar) do { unsigned _sp = 0; while (cond) { __builtin_amdgcn_s_sleep(1); \
    if ((++_sp & 255u) == 0u) { if (xb_ld(&(bar)[XB_TMO])) break; if (_sp > XB_SPIN_CAP) { atomicAdd(&(bar)[XB_TMO], 1u); break; } } } } while (0)

struct XcdBarrier {
    unsigned* bar; unsigned x;
    volatile LAS unsigned* st;
};

__device__ __forceinline__ XcdBarrier xcd_barrier_post(unsigned* bar, volatile LAS unsigned* st) {
    XcdBarrier b; b.bar = bar; b.x = xb_xcc_id(); b.st = st;
    if (threadIdx.x == 0) (void)xb_add(&bar[XB_XCNT(b.x)], 1u);
    return b;
}
__device__ __forceinline__ void xcd_barrier_complete(unsigned* bar, unsigned x, unsigned& nloc, unsigned& nx) {
    const unsigned G = gridDim.x * gridDim.y * gridDim.z;
    unsigned sum, cnt, mine, sp = 0u;
    for (;;) {
        sum = 0u; cnt = 0u; mine = 0u;
#pragma unroll
        for (unsigned j = 0; j < 16; ++j) { const unsigned c = xb_ld(&bar[XB_XCNT(j)]); sum += c; cnt += (c > 0u) ? 1u : 0u; mine = (j == x) ? c : mine; }
        if (sum == G) break;
        __builtin_amdgcn_s_sleep(1);
        if ((++sp & 255u) == 0u) { if (xb_ld(&bar[XB_TMO])) break; if (sp > XB_SPIN_CAP) { atomicAdd(&bar[XB_TMO], 1u); break; } }
    }
    nloc = mine > 0u ? mine : 1u; nx = cnt > 0u ? cnt : 1u;
}

__device__ __forceinline__ void xcd_barrier(const XcdBarrier& b) {
    asm volatile("s_waitcnt vmcnt(0)" ::: "memory");
    __syncthreads();
    if (threadIdx.x == 0) {
        unsigned* bar = b.bar;
        __builtin_amdgcn_s_waitcnt(0);
        unsigned nloc = b.st[0], nx = b.st[1];
        if (nloc == 0u) { xcd_barrier_complete(bar, b.x, nloc, nx); b.st[0] = nloc; b.st[1] = nx; }
        const unsigned old = xb_add(&bar[XB_XSUB(b.x)], 1u);
        const unsigned gen = old / nloc;
        if (old + 1u == (gen + 1u) * nloc) {
            __builtin_amdgcn_fence(__ATOMIC_RELEASE, "agent");
            asm volatile("s_waitcnt vmcnt(0)" ::: "memory");
            const unsigned og = xb_add(&bar[XB_TOP], 1u);
            const unsigned tg = og / nx;
            if (og + 1u == (tg + 1u) * nx) xb_add(&bar[XB_TOPGEN], 1u);
            else XB_SPIN(xb_ld(&bar[XB_TOPGEN]) == tg, bar);
            __builtin_amdgcn_fence(__ATOMIC_ACQUIRE, "agent");
            xb_add(&bar[XB_XGEN(b.x)], 1u);
            asm volatile("s_waitcnt vmcnt(0)" ::: "memory");
        } else {
            XB_SPIN(xb_ld(&bar[XB_XGEN(b.x)]) == gen, bar);
            __builtin_amdgcn_fence(__ATOMIC_ACQUIRE, "agent");
            asm volatile("s_waitcnt vmcnt(0)" ::: "memory");
        }
    }
    __syncthreads();
}

constexpr size_t MiB = 1u << 20;
constexpr size_t WS_CTL = 0, CTL_ZERO_BYTES = 1 * MiB;
constexpr size_t WS_DT = 1 * MiB;
constexpr size_t WS_SSQ = 2 * MiB;
constexpr size_t WS_WIN = 4 * MiB;
constexpr size_t WS_WG = 18 * MiB;
constexpr size_t WS_WSSD = 22 * MiB, WS_WSB = 24 * MiB, WS_WOUT = 26 * MiB;
constexpr size_t WS_XN = 32 * MiB;
constexpr size_t WS_XBC = 64 * MiB;
constexpr size_t WS_Q = 112 * MiB, WS_K = 144 * MiB, WS_V = 176 * MiB;
constexpr size_t WS_XC = 208 * MiB;
constexpr size_t WS_MG1 = 64 * MiB, WS_MG2 = 96 * MiB;
constexpr size_t WS_END = 256 * MiB;
constexpr int CW_BAR = 4096;
constexpr int CW_ATTQ = 64;

constexpr int RING_OFF = 0, RING_BYTES = 131072;
constexpr int LDSCTL_OFF = RING_BYTES, MISC_OFF = LDSCTL_OFF + 320;
constexpr int ROWFAC_OFF = RING_BYTES + 1024;
constexpr int LDS_BYTES = 147456;
static_assert(ROWFAC_OFF + 2048 <= LDS_BYTES && MISC_OFF + 128 <= ROWFAC_OFF, "LDS map");
constexpr int NWAVES = 8;

DI unsigned offb(unsigned row, unsigned ch) { return 256u * row + 16u * (ch ^ (((row & 3u) << 2) | ((row >> 2) & 3u))); }
DI unsigned tr_addr(unsigned lane, unsigned rowbase, unsigned c) { const unsigned blk = (lane >> 4) & 1u, q = (lane & 15u) >> 2, p = lane & 3u; return offb(rowbase + q, 4u * c + 2u * blk + (p >> 1)) + 8u * (p & 1u); }
typedef short v4i16_t __attribute__((ext_vector_type(4)));
DI s16x4 trrd(const LAS unsigned char* p) { return __builtin_bit_cast(s16x4, __builtin_amdgcn_ds_read_tr16_b64_v4i16((LAS v4i16_t*)p)); }
DI bf16x8 cat8(s16x4 lo, s16x4 hi) { return (bf16x8){lo[0], lo[1], lo[2], lo[3], hi[0], hi[1], hi[2], hi[3]}; }
DI bf16x8 tr_nat(const LAS unsigned char* img, unsigned lane, unsigned R0, unsigned c) { const unsigned h = lane >> 5; return cat8(trrd(img + tr_addr(lane, R0 + 8u * h, c)), trrd(img + tr_addr(lane, R0 + 8u * h + 4u, c))); }
DI bf16x8 tr_perm(const LAS unsigned char* img, unsigned lane, unsigned R0, unsigned c) { const unsigned h = lane >> 5; return cat8(trrd(img + tr_addr(lane, R0 + 4u * h, c)), trrd(img + tr_addr(lane, R0 + 8u + 4u * h, c))); }
DI bf16x8 pack8(const f32x16& x, int s) {
    v4u p; p.x = cvtpk(x[8 * s], x[8 * s + 1]); p.y = cvtpk(x[8 * s + 2], x[8 * s + 3]); p.z = cvtpk(x[8 * s + 4], x[8 * s + 5]); p.w = cvtpk(x[8 * s + 6], x[8 * s + 7]); return __builtin_bit_cast(bf16x8, p); }
DI int crow(int r, int hi) { return (r & 3) + 8 * (r >> 2) + 4 * hi; }

struct Frame {
    LAS unsigned char* lds;
    volatile LAS unsigned* MISC;
    gu32* ctl;
    int tid, lane, wave;
    int vcu, G;
    const float *x, *norm_pre, *w_in, *b_gate, *conv_w, *conv_b, *dt_bias, *a_log, *d_skip, *ssd_norm, *w_ssd, *w_sb, *w_out, *norm_post;
    float* out;
    bf16 *Win_t, *Wg_t, *Wssd_t, *Wsb_t, *Wout_t;
    bf16 *XN, *XBC, *XC, *QB, *KB, *VB, *ZS, *ZB, *MG1, *MG2;
    float *DT, *SSQ;
};

DI float wave_sum(float v) {
#pragma unroll
    for (int o = 1; o < 64; o <<= 1) v += __shfl_xor(v, o);
    return v;
}
DI int src_col_inproj(int n) { return n < 2560 ? n : (n < 6656 ? n + 16 : (n < 6672 ? n - 6656 + 2560 : -1)); }
DI void p0_transpose_item(const float* W, int ldw, int K, bf16* WT, int n0, int k0, int mode, const float* kscale, LAS float* scr, int lane) {
    const int nl = lane & 31; const int sc = mode == 1 ? src_col_inproj(n0 + nl) : (mode == 2 ? 6672 + n0 + nl : n0 + nl);
#pragma unroll 8
    for (int i = 0; i < 32; ++i) { const int kk = 2 * i + (lane >> 5); float v = sc >= 0 ? W[(size_t)(k0 + kk) * ldw + sc] : 0.f; if (kscale) v *= kscale[k0 + kk]; scr[kk * 33 + nl] = v; }
    LDS_WAIT(); asm volatile("" ::: "memory");
    const int c = lane & 7;
#pragma unroll
    for (int j = 0; j < 4; ++j) { const int n = (lane >> 3) + 8 * j; const LAS float* s = scr + (8 * c) * 33 + n;
        v4u o; o.x = pk2(s[0 * 33], s[1 * 33]); o.y = pk2(s[2 * 33], s[3 * 33]); o.z = pk2(s[4 * 33], s[5 * 33]); o.w = pk2(s[6 * 33], s[7 * 33]);
        *(GAS v4u*)(WT + (size_t)(n0 + n) * K + k0 + 8 * c) = o; }
    LDS_WAIT(); asm volatile("" ::: "memory");
}
DI void p0_prologue(Frame& F) {
    LAS float* scr = (LAS float*)(F.lds + RING_OFF + F.wave * 16384);
    const int gw = F.vcu * NWAVES + F.wave, NGW = F.G * NWAVES;
    constexpr int I_IN = (NPROJ / 32) * 16, I_G = 64 * 16, I_P = 32 * 16;
    constexpr int NITEMS = I_IN + I_G + 3 * I_P;
    for (int it = gw; it < NITEMS; it += NGW) {
        int r = it;
        if (r < I_IN) { p0_transpose_item(F.w_in, 8720, 1024, F.Win_t, (r >> 4) * 32, (r & 15) * 64, 1, nullptr, scr, F.lane); continue; } r -= I_IN;
        if (r < I_G) { p0_transpose_item(F.w_in, 8720, 1024, F.Wg_t, (r >> 4) * 32, (r & 15) * 64, 2, nullptr, scr, F.lane); continue; } r -= I_G;
        if (r < I_P) { p0_transpose_item(F.w_ssd, 1024, 1024, F.Wssd_t, (r >> 4) * 32, (r & 15) * 64, 0, F.ssd_norm, scr, F.lane); continue; } r -= I_P;
        if (r < I_P) { p0_transpose_item(F.w_sb, 1024, 1024, F.Wsb_t, (r >> 4) * 32, (r & 15) * 64, 0, nullptr, scr, F.lane); continue; } r -= I_P;
        p0_transpose_item(F.w_out, 1024, 1024, F.Wout_t, (r >> 4) * 32, (r & 15) * 64, 0, nullptr, scr, F.lane);
    }
    f32x4 wv[4];
#pragma unroll
    for (int j = 0; j < 4; ++j) wv[j] = ((const GAS f32x4*)F.norm_pre)[F.lane + 64 * j];
    for (int m = gw; m < M; m += NGW) {
        const GAS f32x4* xr = (const GAS f32x4*)(F.x + (size_t)m * DMODEL) + F.lane;
        f32x4 v[4]; float s = 0.f;
#pragma unroll
        for (int j = 0; j < 4; ++j) { v[j] = xr[64 * j]; s += (v[j].x * v[j].x + v[j].y * v[j].y) + (v[j].z * v[j].z + v[j].w * v[j].w); }
        const float rs = 1.f / sqrtf(wave_sum(s) * (1.f / DMODEL) + EPS);
        GAS unsigned long long* o8 = (GAS unsigned long long*)(F.XN + (size_t)m * DMODEL) + F.lane;
#pragma unroll
        for (int j = 0; j < 4; ++j) { const f32x4 o = v[j] * rs * wv[j]; o8[64 * j] = (unsigned long long)pk2(o.x, o.y) | ((unsigned long long)pk2(o.z, o.w) << 32); }
    }
    for (int i = (F.vcu * NWAVES * 64 + F.tid); i < M * 16 / 4; i += F.G * NWAVES * 64) ((GAS f32x4*)F.SSQ)[i] = (f32x4){0.f, 0.f, 0.f, 0.f};
}

DI void p2a_conv(Frame& F) {
    const int gt = F.vcu * NWAVES * 64 + F.tid, NT = F.G * NWAVES * 64;
    constexpr int TB = 16, NITEMS = (M / TB) * (CONVD / 8);
    for (int it = gt; it < NITEMS; it += NT) {
        const int cc = it % (CONVD / 8), blk = it / (CONVD / 8); const int c0 = cc * 8, t0 = blk * TB; const int ts = t0 % SEQ;
        float w[4][8], bias[8];
#pragma unroll
        for (int j = 0; j < 4; ++j) { const f32x4 a = *(const GAS f32x4*)(F.conv_w + j * CONVD + c0), b = *(const GAS f32x4*)(F.conv_w + j * CONVD + c0 + 4);
            w[j][0] = a.x; w[j][1] = a.y; w[j][2] = a.z; w[j][3] = a.w; w[j][4] = b.x; w[j][5] = b.y; w[j][6] = b.z; w[j][7] = b.w; }
        { const f32x4 a = *(const GAS f32x4*)(F.conv_b + c0), b = *(const GAS f32x4*)(F.conv_b + c0 + 4); bias[0] = a.x; bias[1] = a.y; bias[2] = a.z; bias[3] = a.w; bias[4] = b.x; bias[5] = b.y; bias[6] = b.z; bias[7] = b.w; }
        const GAS v4u* src = (const GAS v4u*)(F.XBC + (size_t)t0 * CONVD + c0);
        GAS v4u* dst = (GAS v4u*)(F.XC + (size_t)t0 * CONVD + c0);
        const v4u zero = (v4u){0u, 0u, 0u, 0u};
        v4u r0 = ts >= 3 ? src[-3 * (CONVD / 8)] : zero, r1 = ts >= 2 ? src[-2 * (CONVD / 8)] : zero, r2 = ts >= 1 ? src[-1 * (CONVD / 8)] : zero;
#pragma unroll
        for (int i = 0; i < TB; ++i) {
            const v4u r3 = src[i * (CONVD / 8)];
            float o[8];
#pragma unroll
            for (int e = 0; e < 4; ++e) {
                const unsigned a0 = r0[e], a1 = r1[e], a2 = r2[e], a3 = r3[e];
                const float lo = bias[2 * e] + w[0][2 * e] * bflo(a0) + w[1][2 * e] * bflo(a1) + w[2][2 * e] * bflo(a2) + w[3][2 * e] * bflo(a3);
                const float hi = bias[2 * e + 1] + w[0][2 * e + 1] * bfhi(a0) + w[1][2 * e + 1] * bfhi(a1) + w[2][2 * e + 1] * bfhi(a2) + w[3][2 * e + 1] * bfhi(a3);
                o[2 * e] = silu_f(lo); o[2 * e + 1] = silu_f(hi);
            }
            v4u ov; ov.x = cvtpk(o[0], o[1]); ov.y = cvtpk(o[2], o[3]); ov.z = cvtpk(o[4], o[5]); ov.w = cvtpk(o[6], o[7]);
            dst[i * (CONVD / 8)] = ov;
            r0 = r1; r1 = r2; r2 = r3;
        }
    }
}

constexpr int S_IMB = 0, S_IMC = 16384, S_IMX = 32768, S_IMS = 49152, S_PV = 65536, S_TAB = 98304;
DI void ssd_unit(Frame& F, int b, int h) {
    LAS unsigned char* L = F.lds + RING_OFF;
    const int wid = F.wave, g = h >> 3;
    const float a = -expf(F.a_log[h]), dsk = F.d_skip[h];
    { const int tid = F.tid; for (int i = tid; i < 16384 / 16; i += 512) *(LAS v4u*)((F.lds + RING_OFF) + S_PV + i * 16) = (v4u){0u, 0u, 0u, 0u}; }
    LAS float* tab = (LAS float*)(L + S_TAB);
    f32x16 st0 = {}, st1 = {};
    for (int c = 0; c < SEQ / CHUNK; ++c) {
        const size_t t0 = (size_t)b * SEQ + (size_t)c * CHUNK;
        int tid = F.tid; asm volatile("" : "+v"(tid));
        const int lane = tid & 63, r = lane & 31, hh = lane >> 5;
        for (int idx = tid; idx < 2560; idx += 512) {
            if (idx < 2048) { const int which = idx >> 10, i2 = idx & 1023, row = i2 >> 4, ch = i2 & 15;
                const v4u v = *(const GAS v4u*)(F.XC + (t0 + row) * CONVD + 1024 + which * 256 + g * NS + ch * 8);
                *(LAS v4u*)(L + (which ? S_IMC : S_IMB) + offb(row, ch)) = v;
            } else { const int i2 = idx - 2048, row = i2 >> 3, ch = i2 & 7;
                const v4u v = *(const GAS v4u*)(F.XC + (t0 + row) * CONVD + h * HP + ch * 8);
                *(LAS v4u*)(L + S_IMS + offb(row, ch)) = v; }
        }
        if (wid == 0) {
            const float dtl = F.DT[(t0 + lane) * 16 + h]; float cs = dtl * a;
#pragma unroll
            for (int o = 1; o < 64; o <<= 1) { const float up = __shfl_up(cs, o); if (lane >= o) cs += up; }
            const float tot = __shfl(cs, 63);
            tab[lane] = cs; tab[64 + lane] = fexp2(cs * LOG2E); tab[128 + lane] = dtl; tab[192 + lane] = fexp2((tot - cs) * LOG2E);
            if (lane == 0) tab[256] = fexp2(tot * LOG2E);
        }
        __syncthreads();
        { const int row = tid >> 3, ch = tid & 7; const v4u xv = *(const LAS v4u*)(L + S_IMS + offb(row, ch)); const float dtl = tab[128 + row], dc = tab[192 + row] * dtl;
            v4u o1, o2;
#pragma unroll
            for (int e = 0; e < 4; ++e) { const float lo = bflo(xv[e]), hi = bfhi(xv[e]); o1[e] = cvtpk(lo * dtl, hi * dtl); o2[e] = cvtpk(lo * dc, hi * dc); }
            *(LAS v4u*)(L + S_IMX + offb(row, ch)) = o1; *(LAS v4u*)(L + S_IMX + offb(row, 8 + ch)) = o2; }
        __syncthreads();
        if (wid < 4) {
            const int lb = wid >> 1, pb = wid & 1;
            const LAS unsigned char* PV = L + S_PV + (c & 1) * 16384;
            bf16x8 Cf[8];
#pragma unroll
            for (int s = 0; s < 8; ++s) Cf[s] = *(const LAS bf16x8*)(L + S_IMC + offb(32 * lb + r, 2 * s + hh));
            f32x16 acc = {};
#pragma unroll
            for (int s = 0; s < 8; ++s) { const bf16x8 Pf = *(const LAS bf16x8*)(PV + offb(32 * pb + r, 2 * s + hh)); acc = MFMA32(Cf[s], Pf, acc); }
#pragma unroll
            for (int i = 0; i < 16; ++i) acc[i] *= tab[64 + 32 * lb + crow(i, hh)];
            const float al = tab[32 * lb + r];
            for (int sb = 0; sb <= lb; ++sb) {
                f32x16 X = {};
#pragma unroll
                for (int s = 0; s < 8; ++s) { const bf16x8 Bf = *(const LAS bf16x8*)(L + S_IMB + offb(32 * sb + r, 2 * s + hh)); X = MFMA32(Bf, Cf[s], X); }
#pragma unroll
                for (int i = 0; i < 16; ++i) { const int srow = 32 * sb + crow(i, hh); const float as = tab[srow]; const float dcy = fexp2((al - as) * LOG2E); X[i] = (srow <= 32 * lb + r) ? X[i] * dcy : 0.f; }
#pragma unroll
                for (int s2 = 0; s2 < 2; ++s2) { const bf16x8 Af = pack8(X, s2); const bf16x8 Xf = tr_perm(L + S_IMX, lane, 32 * sb + 16 * s2, pb); acc = MFMA32(Af, Xf, acc); }
            }
            bf16* ZG = F.ZS + t0 * DMODEL + h * HP + 32 * pb + r;
#pragma unroll
            for (int i = 0; i < 16; ++i) { const int l = 32 * lb + crow(i, hh), p = 32 * pb + r;
                const float xv = bf2f(*(const LAS unsigned short*)(L + S_IMS + offb(l, p >> 3) + (p & 7) * 2));
                const float y = acc[i] + dsk * xv; const float z = bf2f(ZG[(size_t)l * DMODEL]); const float gy = y * z;
                ZG[(size_t)l * DMODEL] = (bf16)f2bf(gy);
                float q = gy * gy;
#pragma unroll
                for (int o = 1; o < 32; o <<= 1) q += __shfl_xor(q, o);
                if (r == 0) atomicAdd(F.SSQ + (t0 + l) * 16 + h, q);
            }
        } else {
            const int nb = wid - 4; const float cd = tab[256];
            LAS unsigned char* PVn = L + S_PV + ((c + 1) & 1) * 16384;
#pragma unroll
            for (int i = 0; i < 16; ++i) { st0[i] *= cd; st1[i] *= cd; }
#pragma unroll
            for (int ks = 0; ks < 4; ++ks) { const bf16x8 Af = tr_nat(L + S_IMB, lane, 16 * ks, nb); const bf16x8 B0 = tr_nat(L + S_IMX, lane, 16 * ks, 2), B1 = tr_nat(L + S_IMX, lane, 16 * ks, 3);
                st0 = MFMA32(Af, B0, st0); st1 = MFMA32(Af, B1, st1); }
#pragma unroll
            for (int g4 = 0; g4 < 4; ++g4) { u32x2 w0, w1; w0.x = cvtpk(st0[4 * g4], st0[4 * g4 + 1]); w0.y = cvtpk(st0[4 * g4 + 2], st0[4 * g4 + 3]); w1.x = cvtpk(st1[4 * g4], st1[4 * g4 + 1]); w1.y = cvtpk(st1[4 * g4 + 2], st1[4 * g4 + 3]);
                *(LAS u32x2*)(PVn + offb(r, 4 * nb + g4) + 8 * hh) = w0; *(LAS u32x2*)(PVn + offb(32 + r, 4 * nb + g4) + 8 * hh) = w1; }
        }
        __syncthreads();
    }
}

constexpr int A_IMK = 0, A_IMV = 8192, A_FLG = 16384;
DI void attn_unit(Frame& F, int b, int h, int qb) {
    LAS unsigned char* L = F.lds + RING_OFF;
    const int tid = F.tid, lane = F.lane, wid = F.wave, r = lane & 31, hh = lane >> 5;
    const size_t rowbase = (size_t)b * SEQ; const int q0 = qb * 256 + wid * 32;
    bf16x8 qr[4];
#pragma unroll
    for (int s = 0; s < 4; ++s) qr[s] = *(const GAS bf16x8*)(F.QB + (rowbase + q0 + r) * DMODEL + h * HP + 16 * s + 8 * hh);
    f32x16 o0 = {}, o1 = {}; float carry = 1.f;
    volatile LAS unsigned* flg = (volatile LAS unsigned*)(L + A_FLG);
    const int NT = qb * 4 + 4;
    for (int kt = NT - 1; kt >= 0; --kt) {
        { const int key = tid >> 3, ch = tid & 7; const size_t go = (rowbase + kt * 64 + key) * DMODEL + h * HP + ch * 8;
          const v4u kv = *(const GAS v4u*)(F.KB + go), vv = *(const GAS v4u*)(F.VB + go);
          *(LAS v4u*)(L + A_IMK + offb(key & 31, 8 * (key >> 5) + ch)) = kv; *(LAS v4u*)(L + A_IMV + offb(key & 31, 8 * (key >> 5) + ch)) = vv; }
        __syncthreads();
        const bool live = (kt * 64 < q0 + 31) && !__all(carry == 0.f);
        if (live) {
#pragma unroll
            for (int kb = 1; kb >= 0; --kb) {
                f32x16 p = {};
#pragma unroll
                for (int s = 0; s < 4; ++s) { const bf16x8 Kf = *(const LAS bf16x8*)(L + A_IMK + offb(r, 8 * kb + 2 * s + hh)); p = MFMA32(Kf, qr[s], p); }
                float rr[16], G[4], Go[4];
#pragma unroll
                for (int i = 0; i < 16; ++i) { const int key = kt * 64 + 32 * kb + crow(i, hh); const bool valid = key < q0 + r;
                    const float e = fexp2(fminf(p[i], 100.f)); const float rv = frcp(1.f + e);
                    rr[i] = valid ? rv : 1.f; p[i] = valid ? e * rv : 0.f; }
#pragma unroll
                for (int g4 = 0; g4 < 4; ++g4) { G[g4] = (rr[4 * g4] * rr[4 * g4 + 1]) * (rr[4 * g4 + 2] * rr[4 * g4 + 3]); Go[g4] = __shfl_xor(G[g4], 32); }
                float run = carry;
#pragma unroll
                for (int g4 = 3; g4 >= 0; --g4) {
                    const float f3 = hh ? run : run * Go[g4];
                    const float f2 = f3 * rr[4 * g4 + 3], f1 = f2 * rr[4 * g4 + 2], f0 = f1 * rr[4 * g4 + 1];
                    p[4 * g4 + 3] *= f3; p[4 * g4 + 2] *= f2; p[4 * g4 + 1] *= f1; p[4 * g4] *= f0;
                    run = run * (G[g4] * Go[g4]);
                }
                carry = run;
#pragma unroll
                for (int s2 = 0; s2 < 2; ++s2) { const bf16x8 Pf = pack8(p, s2);
                    const bf16x8 V0 = tr_perm(L + A_IMV, lane, 16 * s2, 2 * kb), V1 = tr_perm(L + A_IMV, lane, 16 * s2, 2 * kb + 1);
                    o0 = MFMA32(Pf, V0, o0); o1 = MFMA32(Pf, V1, o1); }
            }
        }
        const bool done = __all(carry == 0.f) != 0;
        if (lane == 0) flg[wid] = done ? 1u : 0u;
        __syncthreads();
        unsigned alldone = 1u;
#pragma unroll
        for (int w = 0; w < 8; ++w) alldone &= flg[w];
        if (alldone) break;
    }
#pragma unroll
    for (int i = 0; i < 16; ++i) { const int q = q0 + crow(i, hh);
        bf16* zp = F.ZB + (rowbase + q) * DMODEL + h * HP + r;
        const float z0 = bf2f(zp[0]), z1 = bf2f(zp[32]);
        zp[0] = (bf16)f2bf(o0[i] * z0); zp[32] = (bf16)f2bf(o1[i] * z1); }
    __syncthreads();
}

DI void p5_final(Frame& F) {
    const int gw = F.vcu * NWAVES + F.wave, NGW = F.G * NWAVES;
    f32x4 wv[4];
#pragma unroll
    for (int j = 0; j < 4; ++j) wv[j] = ((const GAS f32x4*)F.norm_post)[F.lane + 64 * j];
    for (int m = gw; m < M; m += NGW) {
        GAS f32x4* orow = (GAS f32x4*)(F.out + (size_t)m * DMODEL) + F.lane; const GAS f32x4* xr = (const GAS f32x4*)(F.x + (size_t)m * DMODEL) + F.lane;
        f32x4 v[4], xv[4]; float s = 0.f;
#pragma unroll
        for (int j = 0; j < 4; ++j) { v[j] = orow[64 * j]; xv[j] = xr[64 * j]; s += (v[j].x * v[j].x + v[j].y * v[j].y) + (v[j].z * v[j].z + v[j].w * v[j].w); }
        const float rs = 1.f / sqrtf(wave_sum(s) * (1.f / DMODEL) + EPS);
#pragma unroll
        for (int j = 0; j < 4; ++j) orow[64 * j] = xv[j] + v[j] * rs * wv[j];
    }
}

#ifndef MK_N_LAUNCHES
#define MK_N_LAUNCHES 1
#endif
constexpr int N_LAUNCHES = MK_N_LAUNCHES;
constexpr int PER_PHASE = 7;
struct Args { const float* in[14]; float* out; unsigned char* ws; int ph_lo, ph_hi; };
__global__ void __launch_bounds__(NWAVES * 64, 2) mk_fwd(Args args) {
    extern __shared__ __attribute__((aligned(16))) unsigned char lds[];
    Frame F;
    F.lds = (LAS unsigned char*)lds;
    F.MISC = (volatile LAS unsigned*)(F.lds + MISC_OFF);
    F.tid = threadIdx.x; F.lane = F.tid & 63; F.wave = __builtin_amdgcn_readfirstlane(F.tid >> 6);
    F.G = gridDim.x; { const int bx = blockIdx.x; F.vcu = (F.G % 8 == 0) ? (bx % 8) * (F.G / 8) + bx / 8 : bx; }
    unsigned char* ws = args.ws;
    F.ctl = (gu32*)(ws + WS_CTL);
    F.x = args.in[0]; F.norm_pre = args.in[1]; F.w_in = args.in[2]; F.b_gate = args.in[3]; F.conv_w = args.in[4]; F.conv_b = args.in[5]; F.dt_bias = args.in[6]; F.a_log = args.in[7];
    F.d_skip = args.in[8]; F.ssd_norm = args.in[9]; F.w_ssd = args.in[10]; F.w_sb = args.in[11]; F.w_out = args.in[12]; F.norm_post = args.in[13]; F.out = args.out;
    F.Win_t = (bf16*)(ws + WS_WIN); F.Wg_t = (bf16*)(ws + WS_WG); F.Wssd_t = (bf16*)(ws + WS_WSSD); F.Wsb_t = (bf16*)(ws + WS_WSB); F.Wout_t = (bf16*)(ws + WS_WOUT);
    F.XN = (bf16*)(ws + WS_XN); F.XBC = (bf16*)(ws + WS_XBC); F.XC = (bf16*)(ws + WS_XC); F.QB = (bf16*)(ws + WS_Q); F.KB = (bf16*)(ws + WS_K); F.VB = (bf16*)(ws + WS_V);
    F.ZS = (bf16*)args.out; F.ZB = (bf16*)args.out + (size_t)M * DMODEL; F.MG1 = (bf16*)(ws + WS_MG1); F.MG2 = (bf16*)(ws + WS_MG2);
    F.DT = (float*)(ws + WS_DT); F.SSQ = (float*)(ws + WS_SSQ);
    for (int u = F.tid; u < (LDS_BYTES - LDSCTL_OFF) / 4; u += NWAVES * 64) ((LAS unsigned*)(F.lds + LDSCTL_OFF))[u] = 0u;
    __syncthreads();
    XcdBarrier bar; bar.bar = (unsigned*)(F.ctl + CW_BAR); bar.x = 0; bar.st = nullptr;
    if (N_LAUNCHES != PER_PHASE) bar = xcd_barrier_post((unsigned*)(F.ctl + CW_BAR), F.MISC + 8);
#define GRID_BAR() do { if (N_LAUNCHES != PER_PHASE) xcd_barrier(bar); } while (0)
    const int lo = args.ph_lo, hi = args.ph_hi;
#define IN(k) (lo <= (k) && (k) < hi)
#define BOTH(k) (IN(k) && IN((k) + 1))

    if (IN(0)) {
#ifndef NO_P0
 p0_prologue(F);
#endif
 if (BOTH(0)) GRID_BAR(); }

    if (IN(1)) {
        pg8::Gemm g{}; g.A[0] = g.A[1] = g.A[2] = g.A[3] = F.XN; g.Bt[0] = g.Bt[1] = g.Bt[2] = g.Bt[3] = F.Win_t; g.K = DMODEL;
        pg8::StaticOrder S; S.init(M, NPROJ, F.G, (int)blockIdx.x);
        pg8::EpiProj E{F.ZS, F.XBC, F.QB, F.KB, F.VB, F.ZB, F.DT, F.dt_bias, QSCALE};
#ifndef NO_P1
        pg8::gemm_phase<pg8::EpiProj, pg8::StaticOrder, true, true>(F.lds + RING_OFF, g, S, E);
#endif
        if (BOTH(1)) GRID_BAR();
    }

    if (IN(2)) {
#ifndef NO_P2A
 p2a_conv(F);
#endif
 if (BOTH(2)) GRID_BAR(); }

    if (IN(3)) {
        const int bx = (int)blockIdx.x;
        if (bx < 128) { const int sid = (bx & 7) * 16 + (bx >> 3);
#ifndef NO_SSD
 ssd_unit(F, sid >> 4, sid & 15);
#endif
 }
        for (;;) {
            if (F.tid == 0) F.MISC[16] = __hip_atomic_fetch_add(F.ctl + CW_ATTQ, 1u, RLX_AGENT);
            __syncthreads();
            const unsigned u = F.MISC[16];
            __syncthreads();
            if (u >= (unsigned)(BATCH * NH * (SEQ / 256))) break;
            const int qb = 7 - (int)(u >> 7), bh = (int)(u & 127);
#ifndef NO_ATT
            attn_unit(F, bh >> 4, bh & 15, qb);
#endif
        }
        if (BOTH(3)) GRID_BAR();
    }

    if (IN(4)) {
        pg8::QuadOrder S; S.init(M, DMODEL, F.G, (int)blockIdx.x);
        pg8::Unit u0; const bool has = S.next(0, u0);
        LAS float* rowfac = (LAS float*)(F.lds + ROWFAC_OFF);
        if (has && F.tid < 256) { const GAS f32x4* sp = (const GAS f32x4*)(F.SSQ + (size_t)(u0.pm * 256 + F.tid) * 16);
            const f32x4 a = sp[0], b2 = sp[1], c2 = sp[2], d2 = sp[3];
            const float s0 = (a.x + a.y + a.z + a.w) + (b2.x + b2.y + b2.z + b2.w), s1 = (c2.x + c2.y + c2.z + c2.w) + (d2.x + d2.y + d2.z + d2.w);
            const float r0 = 1.f / sqrtf(s0 * (1.f / 512.f) + EPS), r1 = 1.f / sqrtf(s1 * (1.f / 512.f) + EPS);
            rowfac[F.tid * 2] = r0 / r1; rowfac[F.tid * 2 + 1] = r1; }
        __syncthreads();
        pg8::Gemm g{}; g.A[0] = F.XN; g.A[1] = F.ZS; g.A[2] = F.XN; g.A[3] = F.ZB; g.Bt[0] = F.Wg_t; g.Bt[1] = F.Wssd_t; g.Bt[2] = F.Wg_t + (size_t)1024 * 1024; g.Bt[3] = F.Wsb_t; g.K = DMODEL;
        pg8::EpiMerge E{F.MG1, F.MG2, F.b_gate, (const LAS float*)rowfac};
#ifndef NO_P3
        pg8::gemm_phase<pg8::EpiMerge, pg8::QuadOrder, true, true>(F.lds + RING_OFF, g, S, E);
#endif
        if (BOTH(4)) GRID_BAR();
    }

    if (IN(5)) {
        pg8::Gemm g{}; g.A[0] = g.A[1] = g.A[2] = g.A[3] = F.MG2; g.Bt[0] = g.Bt[1] = g.Bt[2] = g.Bt[3] = F.Wout_t; g.K = DMODEL;
        pg8::StaticOrder S; S.init(M, DMODEL, F.G, (int)blockIdx.x);
        pg8::EpiF32 E{F.out, DMODEL};
#ifndef NO_P4
        pg8::gemm_phase<pg8::EpiF32, pg8::StaticOrder, true, true>(F.lds + RING_OFF, g, S, E);
#endif
        if (BOTH(5)) GRID_BAR();
    }

    #ifndef NO_P5
    if (IN(6)) p5_final(F);
#endif
#undef IN
#undef BOTH
}

extern "C" void kernel_launch(void* const* d_in, const int* in_sizes, int n_in, void* d_out, int out_size, void* d_ws, size_t ws_size, hipStream_t stream) {
    static int grid = 0;
    if (grid == 0) {
        if (n_in != 14 || in_sizes[0] != M * DMODEL || out_size != M * DMODEL || ws_size < WS_END) { fprintf(stderr, "kernel_launch: unexpected shapes (n_in %d, in0 %d, out %d, ws %zu); nothing launched\n", n_in, n_in > 0 ? in_sizes[0] : -1, out_size, ws_size); grid = -1; return; }
        int dev = 0, cus = 0, per_cu = 0;
        if (hipGetDevice(&dev) != hipSuccess || hipDeviceGetAttribute(&cus, hipDeviceAttributeMultiprocessorCount, dev) != hipSuccess) { fprintf(stderr, "kernel_launch: device query failed\n"); grid = -1; return; }
        if (hipFuncSetAttribute((const void*)mk_fwd, hipFuncAttributeMaxDynamicSharedMemorySize, LDS_BYTES) != hipSuccess) { fprintf(stderr, "kernel_launch: hipFuncSetAttribute failed\n"); grid = -1; return; }
        if (hipOccupancyMaxActiveBlocksPerMultiprocessor(&per_cu, (const void*)mk_fwd, NWAVES * 64, LDS_BYTES) != hipSuccess || per_cu < 1) { fprintf(stderr, "kernel_launch: occupancy query says %d blocks per CU; nothing launched\n", per_cu); (void)hipGetLastError(); grid = -1; return; }
        grid = cus;
        if (grid != 256) fprintf(stderr, "kernel_launch: %d CUs; P3 assumes one N=1024 tile per workgroup (256)\n", grid);
    }
    if (grid < 0) return;
    if (hipMemsetAsync((char*)d_ws + WS_CTL, 0, CTL_ZERO_BYTES, stream) != hipSuccess) { fprintf(stderr, "kernel_launch: hipMemsetAsync failed\n"); return; }
    Args a{};
    for (int i = 0; i < 14; ++i) a.in[i] = (const float*)d_in[i];
    a.out = (float*)d_out; a.ws = (unsigned char*)d_ws;
    for (int li = 0; li < N_LAUNCHES; ++li) {
        a.ph_lo = (N_LAUNCHES == PER_PHASE) ? li : 0; a.ph_hi = (N_LAUNCHES == PER_PHASE) ? li + 1 : PER_PHASE;
        hipLaunchKernelGGL(mk_fwd, dim3(grid), dim3(NWAVES * 64), LDS_BYTES, stream, a);
        const hipError_t le = hipPeekAtLastError();
        if (le != hipSuccess) { fprintf(stderr, "kernel_launch: launch %d failed: %s\n", li, hipGetErrorName(le)); break; }
    }
}
```

```cpp
#include <hip/hip_runtime.h>
#ifndef PROBE_DUP
#define PROBE_DUP 0
#endif
#include <cstdio>
#include <cstdint>

#define GAS __attribute__((address_space(1)))
#define LAS __attribute__((address_space(3)))
#define DI __device__ __forceinline__
typedef unsigned short bf16;
typedef unsigned v4u __attribute__((ext_vector_type(4)));
typedef unsigned u32x2 __attribute__((ext_vector_type(2)));
typedef float f32x4 __attribute__((ext_vector_type(4)));
typedef float f32x2 __attribute__((ext_vector_type(2)));
typedef float f32x16 __attribute__((ext_vector_type(16)));
typedef short bf16x8 __attribute__((ext_vector_type(8)));
typedef short s16x4 __attribute__((ext_vector_type(4)));
typedef __bf16 bf16x2_t __attribute__((ext_vector_type(2)));
typedef GAS unsigned gu32;
typedef GAS unsigned long long gu64;
#define RLX_AGENT __ATOMIC_RELAXED, __HIP_MEMORY_SCOPE_AGENT
#define LDS_WAIT() asm volatile("s_waitcnt lgkmcnt(0)" ::: "memory")
#define VM_WAIT() asm volatile("s_waitcnt vmcnt(0)" ::: "memory")
DI unsigned f2bf(float f) { unsigned u = __builtin_bit_cast(unsigned, f); return (u + 0x7fffu + ((u >> 16) & 1u)) >> 16; }
DI unsigned pk2(float lo, float hi) { return f2bf(lo) | (f2bf(hi) << 16); }
DI unsigned cvtpk(float lo, float hi) { f32x2 v = {lo, hi}; bf16x2_t b = __builtin_convertvector(v, bf16x2_t); return __builtin_bit_cast(unsigned, b); }
DI float bflo(unsigned w) { return __uint_as_float(w << 16); }
DI float bfhi(unsigned w) { return __uint_as_float(w & 0xffff0000u); }
DI float bf2f(unsigned short u) { return __uint_as_float((unsigned)u << 16); }
constexpr float LOG2E = 1.4426950408889634f;
DI float fexp2(float x) { return __builtin_amdgcn_exp2f(x); }
DI float frcp(float x) { return __builtin_amdgcn_rcpf(x); }
DI float silu_f(float v) { return v * frcp(1.f + fexp2(-v * LOG2E)); }
DI float sigm_f(float v) { return frcp(1.f + fexp2(-v * LOG2E)); }
#define MFMA32(a, b, c) __builtin_amdgcn_mfma_f32_32x32x16_bf16((a), (b), (c), 0, 0, 0)

constexpr int BATCH = 8, SEQ = 2048, DMODEL = 1024, M = BATCH * SEQ;
constexpr int NH = 16, HP = 64, NS = 128, CONVD = 1536, CHUNK = 64;
constexpr int NPROJ = 6912;
constexpr float EPS = 1e-6f;
constexpr float QSCALE = 0.125f * LOG2E;

namespace pg8 {
#define PG8_LAS __attribute__((address_space(3)))
typedef unsigned short bf16_t;
typedef short bf16x8 __attribute__((ext_vector_type(8)));
typedef float f32x4 __attribute__((ext_vector_type(4)));
typedef unsigned u32x4 __attribute__((ext_vector_type(4)));
constexpr int BM = 256, BK = 64, HALF = 128, HTB = HALF * BK * 2  , STAGE_BYTES = 8 * HTB, NXCD = 8, WGM = 8;

__host__ __device__ __forceinline__ int lds_byte(int r, int c) { const int st = (r >> 4) * 2 + (c >> 5), rr = r & 15, cc = c & 31, ob = rr * 64 + cc * 2; return st * 1024 + (ob ^ (((ob >> 9) & 1) << 5)); }
__host__ __device__ __forceinline__ void stage_rc(int b, int& R, int& C) { const int st = b / 1024, sb = b % 1024, swz = sb ^ (((sb >> 9) & 1) << 5); R = (st >> 1) * 16 + swz / 64; C = (st & 1) * 32 + (swz % 64) / 2; }
__host__ __device__ __forceinline__ int perm32(int rho) { const int n = rho >> 4, i = rho & 15; return 8 * (i >> 2) + 4 * n + (i & 3); }

struct Unit { int pm, pn, kind; };
struct Gemm { const bf16_t* A[4]; const bf16_t* Bt[4]; int K; };
__device__ __forceinline__ const char* a_base(const Gemm& g, int k) { return (const char*)(k == 0 ? g.A[0] : (k == 1 ? g.A[1] : (k == 2 ? g.A[2] : g.A[3]))); }
__device__ __forceinline__ const char* b_base(const Gemm& g, int k) { return (const char*)(k == 0 ? g.Bt[0] : (k == 1 ? g.Bt[1] : (k == 2 ? g.Bt[2] : g.Bt[3]))); }

struct StaticOrder {
    int nM, nN, nwg, G, c;
    __host__ __device__ void init(int M_, int N_, int G_, int c_) { nM = M_ / BM; nN = N_ / BM; nwg = nM * nN; G = G_; c = c_; }
    __host__ __device__ bool next(int i, Unit& u) const {
        const long L = (long)i * G + c; if (L >= nwg) return false;
        int wgid = (int)L; { const int q = nwg / NXCD, r = nwg % NXCD, xcd = wgid % NXCD, off = wgid / NXCD; wgid = (xcd < r ? xcd * (q + 1) : r * (q + 1) + (xcd - r) * q) + off; }
        const int nig = WGM * nN, gid = wgid / nig, fm = gid * WGM, gsz = (nM - fm) < WGM ? (nM - fm) : WGM;
        u.pm = fm + ((wgid % nig) % gsz); u.pn = (wgid % nig) / gsz; u.kind = 0; return true;
    }
    __device__ __forceinline__ void a_ready(const Unit&) const {}
    __device__ __forceinline__ void done(const Unit&) const {}
};
struct QuadOrder {
    StaticOrder so;
    __device__ void init(int M_, int N_, int G_, int c_) { so.init(M_, N_, G_, c_); }
    __device__ bool next(int i, Unit& u) const { if (!so.next(i >> 2, u)) return false; u.kind = i & 3; return true; }
    __device__ __forceinline__ void a_ready(const Unit&) const {}
    __device__ __forceinline__ void done(const Unit&) const {}
};
__device__ __forceinline__ unsigned cvt_pk_bf16(float lo, float hi) { unsigned r; asm volatile("v_cvt_pk_bf16_f32 %0, %1, %2" : "=v"(r) : "v"(lo), "v"(hi)); return r; }

__device__ __forceinline__ float silu1(float v) { return v * __builtin_amdgcn_rcpf(1.f + __builtin_amdgcn_exp2f(-v * 1.4426950408889634f)); }
__device__ __forceinline__ float sigm1(float v) { return __builtin_amdgcn_rcpf(1.f + __builtin_amdgcn_exp2f(-v * 1.4426950408889634f)); }
__device__ __forceinline__ float bl(unsigned w) { return __uint_as_float(w << 16); }
__device__ __forceinline__ float bh(unsigned w) { return __uint_as_float(w & 0xffff0000u); }

struct EpiProj {
    static constexpr bool PERM = true, AFTER_DRAIN = false, MIDK = false;
    bf16_t *ZS, *XBC, *Q, *K, *V, *ZB; float* DT; const float* dt_bias; float qscale;
    __device__ __forceinline__ void midk(f32x4 (&)[2][2][4][2], const Unit&, int, int, int, int) const {}
    __device__ __forceinline__ void operator()(const f32x4 (&acc)[2][2][4][2], const Unit& u, int wr, int wc, int fr, int fq) const {
        const int pn = u.pn; const int row0 = u.pm * BM + wr * 64 + fr;
        if (pn == 26) {
            if (wc == 0 && fq < 2) {
#pragma unroll
                for (int ai = 0; ai < 2; ++ai)
#pragma unroll
                    for (int m = 0; m < 4; ++m) { float* rp = DT + (size_t)(row0 + ai * HALF + m * 16) * 16 + 8 * fq;
#pragma unroll
                        for (int n = 0; n < 2; ++n) { f32x4 o;
#pragma unroll
                            for (int e = 0; e < 4; ++e) { const float raw = acc[ai][0][m][n][e] + dt_bias[8 * fq + 4 * n + e]; o[e] = raw > 20.f ? raw : log1pf(expf(raw)); }
                            *(f32x4*)(rp + 4 * n) = o; } }
            }
            return;
        }
        bf16_t* base; int ldc, colt; bool act = false; float sc = 1.f;
        if (pn < 4) { base = ZS; ldc = 1024; colt = pn * 256; act = true; }
        else if (pn < 10) { base = XBC; ldc = 1536; colt = (pn - 4) * 256; }
        else if (pn < 14) { base = Q; ldc = 1024; colt = (pn - 10) * 256; sc = qscale; }
        else if (pn < 18) { base = K; ldc = 1024; colt = (pn - 14) * 256; }
        else if (pn < 22) { base = V; ldc = 1024; colt = (pn - 18) * 256; }
        else { base = ZB; ldc = 1024; colt = (pn - 22) * 256; act = true; }
        const int col0 = colt + wc * 32 + 8 * fq;
#pragma unroll
        for (int ai = 0; ai < 2; ++ai)
#pragma unroll
            for (int m = 0; m < 4; ++m) { bf16_t* rowp = base + (size_t)(row0 + ai * HALF + m * 16) * ldc + col0;
#pragma unroll
                for (int bj = 0; bj < 2; ++bj) { f32x4 v0 = acc[ai][bj][m][0], v1 = acc[ai][bj][m][1];
                    if (act) {
#pragma unroll
                        for (int e = 0; e < 4; ++e) { v0[e] = silu1(v0[e]); v1[e] = silu1(v1[e]); } }
                    v0 = v0 * sc; v1 = v1 * sc; u32x4 w; w.x = cvt_pk_bf16(v0[0], v0[1]); w.y = cvt_pk_bf16(v0[2], v0[3]); w.z = cvt_pk_bf16(v1[0], v1[1]); w.w = cvt_pk_bf16(v1[2], v1[3]);
                    *(u32x4*)(rowp + bj * HALF) = w; } }
    }
};

struct EpiMerge {
    static constexpr bool PERM = true, AFTER_DRAIN = false, MIDK = true;
    bf16_t *MG1, *MG2; const float* bg; const PG8_LAS float* rowfac;
    __device__ __forceinline__ void midk(f32x4 (&acc)[2][2][4][2], const Unit& u, int wr, int wc, int fr, int fq) const {
        if (u.kind != 1) return;
#pragma unroll
        for (int ai = 0; ai < 2; ++ai)
#pragma unroll
            for (int m = 0; m < 4; ++m) { const float f = rowfac[(ai * HALF + wr * 64 + m * 16 + fr) * 2];
#pragma unroll
                for (int bj = 0; bj < 2; ++bj)
#pragma unroll
                    for (int n = 0; n < 2; ++n) acc[ai][bj][m][n] = acc[ai][bj][m][n] * f; }
    }
    __device__ __forceinline__ void operator()(const f32x4 (&acc)[2][2][4][2], const Unit& u, int wr, int wc, int fr, int fq) const {
        const int kind = u.kind; const int row0 = u.pm * BM + wr * 64 + fr, col0 = u.pn * BM + wc * 32 + 8 * fq;
        f32x4 bv[2][2];
#pragma unroll
        for (int bj = 0; bj < 2; ++bj)
#pragma unroll
            for (int n = 0; n < 2; ++n) bv[bj][n] = (kind == 0 || kind == 2) ? *(const f32x4*)(bg + (kind == 2 ? 1024 : 0) + col0 + bj * HALF + 4 * n) : (f32x4){0.f, 0.f, 0.f, 0.f};
#pragma unroll
        for (int ai = 0; ai < 2; ++ai)
#pragma unroll
            for (int m = 0; m < 4; ++m) { const int rl = ai * HALF + wr * 64 + m * 16 + fr; const size_t off = (size_t)(row0 + ai * HALF + m * 16) * 1024 + col0;
                const float rs1 = (kind == 1) ? rowfac[rl * 2 + 1] : 1.f;
#pragma unroll
                for (int bj = 0; bj < 2; ++bj) { f32x4 v0 = acc[ai][bj][m][0], v1 = acc[ai][bj][m][1]; bf16_t* dst;
                    if (kind == 0 || kind == 2) {
#pragma unroll
                        for (int e = 0; e < 4; ++e) { v0[e] = sigm1(v0[e] + bv[bj][0][e]); v1[e] = sigm1(v1[e] + bv[bj][1][e]); }
                        dst = (kind == 0 ? MG1 : MG2) + off + bj * HALF;
                    } else if (kind == 1) {
                        const u32x4 g = *(const u32x4*)(MG1 + off + bj * HALF);
                        v0[0] *= rs1 * bl(g.x); v0[1] *= rs1 * bh(g.x); v0[2] *= rs1 * bl(g.y); v0[3] *= rs1 * bh(g.y);
                        v1[0] *= rs1 * bl(g.z); v1[1] *= rs1 * bh(g.z); v1[2] *= rs1 * bl(g.w); v1[3] *= rs1 * bh(g.w);
                        dst = MG1 + off + bj * HALF;
                    } else {
                        const u32x4 a = *(const u32x4*)(MG1 + off + bj * HALF); const u32x4 g = *(const u32x4*)(MG2 + off + bj * HALF);
                        v0[0] = bl(a.x) + bl(g.x) * v0[0]; v0[1] = bh(a.x) + bh(g.x) * v0[1]; v0[2] = bl(a.y) + bl(g.y) * v0[2]; v0[3] = bh(a.y) + bh(g.y) * v0[3];
                        v1[0] = bl(a.z) + bl(g.z) * v1[0]; v1[1] = bh(a.z) + bh(g.z) * v1[1]; v1[2] = bl(a.w) + bl(g.w) * v1[2]; v1[3] = bh(a.w) + bh(g.w) * v1[3];
                        dst = MG2 + off + bj * HALF;
                    }
                    u32x4 w; w.x = cvt_pk_bf16(v0[0], v0[1]); w.y = cvt_pk_bf16(v0[2], v0[3]); w.z = cvt_pk_bf16(v1[0], v1[1]); w.w = cvt_pk_bf16(v1[2], v1[3]);
                    *(u32x4*)dst = w; } }
    }
};

struct EpiF32 {
    static constexpr bool PERM = false, AFTER_DRAIN = false, MIDK = false;
    float* out; int ldc;
    __device__ __forceinline__ void midk(f32x4 (&)[2][2][4][2], const Unit&, int, int, int, int) const {}
    __device__ __forceinline__ void operator()(const f32x4 (&acc)[2][2][4][2], const Unit& u, int wr, int wc, int fr, int fq) const {
        const int row0 = u.pm * BM + wr * 64 + fr, col0 = u.pn * BM + wc * 32 + 4 * fq;
#pragma unroll
        for (int ai = 0; ai < 2; ++ai)
#pragma unroll
            for (int m = 0; m < 4; ++m) { float* rowp = out + (size_t)(row0 + ai * HALF + m * 16) * ldc + col0;
#pragma unroll
                for (int bj = 0; bj < 2; ++bj)
#pragma unroll
                    for (int n = 0; n < 2; ++n) *(f32x4*)(rowp + bj * HALF + n * 16) = acc[ai][bj][m][n]; }
    }
};

template <class Epi, class Sched, bool ALIGN_EPI = false, bool SP2 = false>
__device__ __forceinline__ void gemm_phase(PG8_LAS unsigned char* lds, const Gemm g, const Sched& S, const Epi& E) {
    const int tid = threadIdx.x, wid = __builtin_amdgcn_readfirstlane(tid >> 6), lane = tid & 63, wr = wid >> 2, wc = wid & 3, fr = lane & 15, fq = lane >> 4;
    const int K = g.K, nt = K / BK;
    unsigned voffA[2], voffB[2];
#pragma unroll
    for (int i = 0; i < 2; ++i) { int R, C; stage_rc(tid * 16 + i * 8192, R, C); const int Rb = Epi::PERM ? ((R & ~31) + perm32(R & 31)) : R;
        voffA[i] = (unsigned)(R * K + C) * 2u; voffB[i] = (unsigned)(Rb * K + C) * 2u; }
    const size_t kstep = (size_t)(BK * 2);
    const size_t hstep = (size_t)HALF * K * 2;
    const size_t tstep = 2 * hstep;
    const unsigned ldsw = (unsigned)wid * 1024u;
    const int aoff = lds_byte(wr * 64 + fr, fq * 8), boff = lds_byte(wc * 32 + fr, fq * 8);
#define PG8_SA(b, h) (((b) * 2 + (h)) * HTB)
#define PG8_SB(b, h) ((4 + (b) * 2 + (h)) * HTB)
#define PG8_STAGE(bufoff, gbase, voff) do { _Pragma("unroll") for (int _i = 0; _i < 2; ++_i) \
        __builtin_amdgcn_global_load_lds((const unsigned*)((const char*)(gbase) + (voff)[_i]), (PG8_LAS unsigned*)(lds + (bufoff) + ldsw + _i * 8192), 16, 0, 0); } while (0)
#define PG8_LDA(dst, b, h) do { _Pragma("unroll") for (int m = 0; m < 4; ++m) _Pragma("unroll") for (int k = 0; k < 2; ++k) dst[m][k] = *(const PG8_LAS bf16x8*)(lds + PG8_SA(b, h) + aoff + m * 2048 + k * 1024); } while (0)
#define PG8_LDB(dst, b, h) do { _Pragma("unroll") for (int n = 0; n < 2; ++n) _Pragma("unroll") for (int k = 0; k < 2; ++k) dst[n][k] = *(const PG8_LAS bf16x8*)(lds + PG8_SB(b, h) + boff + n * 2048 + k * 1024); } while (0)
#define PG8_MMA(ai, bj, At, Bt) do { __builtin_amdgcn_s_setprio(1); _Pragma("unroll") for (int m = 0; m < 4; ++m) _Pragma("unroll") for (int n = 0; n < 2; ++n) _Pragma("unroll") for (int k = 0; k < 2; ++k) \
        acc[ai][bj][m][n] = __builtin_amdgcn_mfma_f32_16x16x32_bf16(Bt[n][k], At[m][k], acc[ai][bj][m][n], 0, 0, 0); __builtin_amdgcn_s_setprio(0); } while (0)
#define PG8_WAIT_V(n) asm volatile("s_waitcnt vmcnt(" #n ")" ::: "memory")
#define PG8_WAIT_L(n) asm volatile("s_waitcnt lgkmcnt(" #n ")" ::: "memory")
#define PG8_BAR __builtin_amdgcn_s_barrier()
#define PG8_SCHED __builtin_amdgcn_sched_barrier(0)
    Unit cur, nxt; int ui = 0;
    if (!S.next(0, cur)) return;
    f32x4 acc[2][2][4][2];
#pragma unroll
    for (int a = 0; a < 2; ++a)
#pragma unroll
        for (int b = 0; b < 2; ++b)
#pragma unroll
            for (int m = 0; m < 4; ++m)
#pragma unroll
                for (int n = 0; n < 2; ++n) acc[a][b][m][n] = (f32x4){0.f, 0.f, 0.f, 0.f};
    bf16x8 At[4][2], B0[2][2], B1[2][2];
    const char* cA = a_base(g, cur.kind) + (size_t)cur.pm * tstep; const char* cB = b_base(g, cur.kind) + (size_t)cur.pn * tstep;
    S.a_ready(cur);
    if constexpr (SP2) {
        PG8_STAGE(PG8_SB(0, 0), cB, voffB); PG8_STAGE(PG8_SB(0, 1), cB + hstep, voffB); PG8_STAGE(PG8_SA(0, 0), cA, voffA); PG8_STAGE(PG8_SA(0, 1), cA + hstep, voffA);
        if (wr == 1) PG8_BAR;
        PG8_WAIT_V(2); PG8_BAR;
        PG8_STAGE(PG8_SB(1, 0), cB + kstep, voffB); PG8_STAGE(PG8_SA(1, 0), cA + kstep, voffA); PG8_STAGE(PG8_SB(1, 1), cB + hstep + kstep, voffB);
        PG8_WAIT_V(6); PG8_BAR;
    } else {
        PG8_STAGE(PG8_SB(0, 0), cB, voffB); PG8_STAGE(PG8_SA(0, 0), cA, voffA); PG8_STAGE(PG8_SB(0, 1), cB + hstep, voffB); PG8_STAGE(PG8_SA(0, 1), cA + hstep, voffA);
        if (wr == 1) PG8_BAR;
        PG8_WAIT_V(4); PG8_BAR;
        PG8_STAGE(PG8_SB(1, 0), cB + kstep, voffB); PG8_STAGE(PG8_SA(1, 0), cA + kstep, voffA); PG8_STAGE(PG8_SB(1, 1), cB + hstep + kstep, voffB);
        PG8_WAIT_V(6); PG8_BAR;
    }
    for (;;) {
        const bool has_next = S.next(ui + 1, nxt);
        const char* nA = has_next ? a_base(g, nxt.kind) + (size_t)nxt.pm * tstep : cA; const char* nB = has_next ? b_base(g, nxt.kind) + (size_t)nxt.pn * tstep : cB;
        for (int t = 0; t < nt; t += 2) {
            const bool last = (t == nt - 2);
            if constexpr (Epi::MIDK) { if (t == nt / 2) E.midk(acc, cur, wr, wc, fr, fq); }
            const char* a1 = cA + (size_t)(t + 1) * kstep;
            const char* a2 = last ? nA : cA + (size_t)(t + 2) * kstep; const char* b2 = last ? nB : cB + (size_t)(t + 2) * kstep;
            const char* a3 = a2 + kstep; const char* b3 = b2 + kstep;
            if (last && has_next) S.a_ready(nxt);
            if constexpr (SP2) {
            PG8_LDB(B0, 0, 0); PG8_LDB(B1, 0, 1); PG8_SCHED; PG8_LDA(At, 0, 0); PG8_STAGE(PG8_SA(1, 1), a1 + hstep, voffA);
            PG8_WAIT_V(8); PG8_WAIT_L(0); PG8_BAR; PG8_MMA(0, 0, At, B0); PG8_MMA(0, 1, At, B1); PG8_BAR; PG8_SCHED;
            PG8_LDA(At, 0, 1); PG8_STAGE(PG8_SB(0, 0), b2, voffB); PG8_STAGE(PG8_SB(0, 1), b2 + hstep, voffB); PG8_STAGE(PG8_SA(0, 0), a2, voffA);
            PG8_WAIT_V(8); PG8_WAIT_L(0); PG8_BAR; PG8_MMA(1, 0, At, B0); PG8_MMA(1, 1, At, B1); PG8_BAR; PG8_SCHED;
            PG8_LDB(B0, 1, 0); PG8_LDB(B1, 1, 1); PG8_SCHED; PG8_LDA(At, 1, 0); PG8_STAGE(PG8_SA(0, 1), a2 + hstep, voffA);
            PG8_WAIT_V(8); PG8_WAIT_L(0); PG8_BAR; PG8_MMA(0, 0, At, B0); PG8_MMA(0, 1, At, B1); PG8_BAR; PG8_SCHED;
            PG8_LDA(At, 1, 1); PG8_STAGE(PG8_SB(1, 0), b3, voffB); PG8_STAGE(PG8_SB(1, 1), b3 + hstep, voffB); PG8_STAGE(PG8_SA(1, 0), a3, voffA);
            PG8_WAIT_V(8); PG8_WAIT_L(0); PG8_BAR; PG8_MMA(1, 0, At, B0); PG8_MMA(1, 1, At, B1); PG8_BAR; PG8_SCHED;
            } else {
            PG8_LDB(B0, 0, 0); PG8_SCHED; PG8_LDA(At, 0, 0); PG8_STAGE(PG8_SA(1, 1), a1 + hstep, voffA);
            PG8_WAIT_L(8); PG8_BAR; PG8_WAIT_L(0); PG8_MMA(0, 0, At, B0); PG8_BAR; PG8_SCHED;
            PG8_LDB(B1, 0, 1); PG8_STAGE(PG8_SB(0, 0), b2, voffB);
            PG8_BAR; PG8_WAIT_L(0); PG8_MMA(0, 1, At, B1); PG8_BAR;
            PG8_LDA(At, 0, 1); PG8_STAGE(PG8_SA(0, 0), a2, voffA);
            PG8_BAR; PG8_WAIT_L(0); PG8_MMA(1, 0, At, B0); PG8_BAR; PG8_SCHED;
            PG8_STAGE(PG8_SB(0, 1), b2 + hstep, voffB);
            PG8_WAIT_V(6); PG8_BAR; PG8_MMA(1, 1, At, B1); PG8_BAR;
            PG8_LDB(B0, 1, 0); PG8_SCHED; PG8_LDA(At, 1, 0); PG8_STAGE(PG8_SA(0, 1), a2 + hstep, voffA);
            PG8_WAIT_L(8); PG8_BAR; PG8_WAIT_L(0); PG8_MMA(0, 0, At, B0); PG8_BAR; PG8_SCHED;
            PG8_LDB(B1, 1, 1); PG8_STAGE(PG8_SB(1, 0), b3, voffB);
            PG8_BAR; PG8_WAIT_L(0); PG8_MMA(0, 1, At, B1); PG8_BAR;
            PG8_LDA(At, 1, 1); PG8_STAGE(PG8_SA(1, 0), a3, voffA);
            PG8_BAR; PG8_WAIT_L(0); PG8_MMA(1, 0, At, B0); PG8_BAR; PG8_SCHED;
            PG8_STAGE(PG8_SB(1, 1), b3 + hstep, voffB);
            PG8_WAIT_V(6); PG8_BAR; PG8_MMA(1, 1, At, B1); PG8_BAR;
            }
        }
        if constexpr (ALIGN_EPI) { if (wr == 0) PG8_BAR; }
        if constexpr (!Epi::AFTER_DRAIN) { E(acc, cur, wr, wc, fr, fq); S.done(cur); }
        if (!has_next) break;
#pragma unroll
        for (int a = 0; a < 2; ++a)
#pragma unroll
            for (int b = 0; b < 2; ++b)
#pragma unroll
                for (int m = 0; m < 4; ++m)
#pragma unroll
                    for (int n = 0; n < 2; ++n) acc[a][b][m][n] = (f32x4){0.f, 0.f, 0.f, 0.f};
        cur = nxt; cA = nA; cB = nB; ++ui;
        if constexpr (ALIGN_EPI) { if (wr == 1) PG8_BAR; }
    }
    PG8_WAIT_V(0);
    if constexpr (!ALIGN_EPI) { if (wr == 0) PG8_BAR; }
    PG8_BAR;
    if constexpr (Epi::AFTER_DRAIN) { E.fused(acc, cur, wr, wc, fr, fq, lds, wid, lane); S.done(cur); }
#undef PG8_SA
#undef PG8_SB
#undef PG8_STAGE
#undef PG8_LDA
#undef PG8_LDB
#undef PG8_MMA
#undef PG8_WAIT_V
#undef PG8_WAIT_L
#undef PG8_BAR
#undef PG8_SCHED
}
}

#define XB_TMO      128
#define XB_XCNT(j)  (256  + 64 * (j))
#define XB_XSUB(j)  (1280 + 64 * (j))
#define XB_XGEN(j)  (2304 + 64 * (j))
#define XB_TOP      3328
#define XB_TOPGEN   3392
#define XCD_BAR_WORDS 3456
#define XB_SPIN_CAP (1u << 18)

__device__ __forceinline__ unsigned xb_ld(unsigned* p)              { return __hip_atomic_load(p, __ATOMIC_RELAXED, __HIP_MEMORY_SCOPE_AGENT); }
__device__ __forceinline__ unsigned xb_add(unsigned* p, unsigned v) { return __hip_atomic_fetch_add(p, v, __ATOMIC_RELAXED, __HIP_MEMORY_SCOPE_AGENT); }
__device__ __forceinline__ unsigned xb_xcc_id() { return (unsigned)__builtin_amdgcn_s_getreg((3 << 11) | 20) & 0xFu; }
#define XB_SPIN(cond, bar) do { unsigned _sp = 0; while (cond) { __builtin_amdgcn_s_sleep(1); \
    if ((++_sp & 255u) == 0u) { if (xb_ld(&(bar)[XB_TMO])) break; if (_sp > XB_SPIN_CAP) { atomicAdd(&(bar)[XB_TMO], 1u); break; } } } } while (0)

struct XcdBarrier {
    unsigned* bar; unsigned x;
    volatile LAS unsigned* st;
};

__device__ __forceinline__ XcdBarrier xcd_barrier_post(unsigned* bar, volatile LAS unsigned* st) {
    XcdBarrier b; b.bar = bar; b.x = xb_xcc_id(); b.st = st;
    if (threadIdx.x == 0) (void)xb_add(&bar[XB_XCNT(b.x)], 1u);
    return b;
}
__device__ __forceinline__ void xcd_barrier_complete(unsigned* bar, unsigned x, unsigned& nloc, unsigned& nx) {
    const unsigned G = gridDim.x * gridDim.y * gridDim.z;
    unsigned sum, cnt, mine, sp = 0u;
    for (;;) {
        sum = 0u; cnt = 0u; mine = 0u;
#pragma unroll
        for (unsigned j = 0; j < 16; ++j) { const unsigned c = xb_ld(&bar[XB_XCNT(j)]); sum += c; cnt += (c > 0u) ? 1u : 0u; mine = (j == x) ? c : mine; }
        if (sum == G) break;
        __builtin_amdgcn_s_sleep(1);
        if ((++sp & 255u) == 0u) { if (xb_ld(&bar[XB_TMO])) break; if (sp > XB_SPIN_CAP) { atomicAdd(&bar[XB_TMO], 1u); break; } }
    }
    nloc = mine > 0u ? mine : 1u; nx = cnt > 0u ? cnt : 1u;
}

__device__ __forceinline__ void xcd_barrier(const XcdBarrier& b) {
    asm volatile("s_waitcnt vmcnt(0)" ::: "memory");
    __syncthreads();
    if (threadIdx.x == 0) {
        unsigned* bar = b.bar;
        __builtin_amdgcn_s_waitcnt(0);
        unsigned nloc = b.st[0], nx = b.st[1];
        if (nloc == 0u) { xcd_barrier_complete(bar, b.x, nloc, nx); b.st[0] = nloc; b.st[1] = nx; }
        const unsigned old = xb_add(&bar[XB_XSUB(b.x)], 1u);
        const unsigned gen = old / nloc;
        if (old + 1u == (gen + 1u) * nloc) {
            __builtin_amdgcn_fence(__ATOMIC_RELEASE, "agent");
            asm volatile("s_waitcnt vmcnt(0)" ::: "memory");
            const unsigned og = xb_add(&bar[XB_TOP], 1u);
            const unsigned tg = og / nx;
            if (og + 1u == (tg + 1u) * nx) xb_add(&bar[XB_TOPGEN], 1u);
            else XB_SPIN(xb_ld(&bar[XB_TOPGEN]) == tg, bar);
            __builtin_amdgcn_fence(__ATOMIC_ACQUIRE, "agent");
            xb_add(&bar[XB_XGEN(b.x)], 1u);
            asm volatile("s_waitcnt vmcnt(0)" ::: "memory");
        } else {
            XB_SPIN(xb_ld(&bar[XB_XGEN(b.x)]) == gen, bar);
            __builtin_amdgcn_fence(__ATOMIC_ACQUIRE, "agent");
            asm volatile("s_waitcnt vmcnt(0)" ::: "memory");
        }
    }
    __syncthreads();
}

constexpr size_t MiB = 1u << 20;
constexpr size_t WS_CTL = 0, CTL_ZERO_BYTES = 1 * MiB;
constexpr size_t WS_DT = 1 * MiB;
constexpr size_t WS_SSQ = 2 * MiB;
constexpr size_t WS_WIN = 4 * MiB;
constexpr size_t WS_WG = 18 * MiB;
constexpr size_t WS_WSSD = 22 * MiB, WS_WSB = 24 * MiB, WS_WOUT = 26 * MiB;
constexpr size_t WS_XN = 32 * MiB;
constexpr size_t WS_XBC = 64 * MiB;
constexpr size_t WS_Q = 112 * MiB, WS_K = 144 * MiB, WS_V = 176 * MiB;
constexpr size_t WS_XC = 208 * MiB;
constexpr size_t WS_MG1 = 64 * MiB, WS_MG2 = 96 * MiB;
constexpr size_t WS_END = 256 * MiB;
constexpr int CW_BAR = 4096;
constexpr int CW_ATTQ = 64;

constexpr int RING_OFF = 0, RING_BYTES = 131072;
constexpr int LDSCTL_OFF = RING_BYTES, MISC_OFF = LDSCTL_OFF + 320;
constexpr int ROWFAC_OFF = RING_BYTES + 1024;
constexpr int LDS_BYTES = 147456;
static_assert(ROWFAC_OFF + 2048 <= LDS_BYTES && MISC_OFF + 128 <= ROWFAC_OFF, "LDS map");
constexpr int NWAVES = 8;

DI unsigned offb(unsigned row, unsigned ch) { return 256u * row + 16u * (ch ^ (((row & 3u) << 2) | ((row >> 2) & 3u))); }
DI unsigned tr_addr(unsigned lane, unsigned rowbase, unsigned c) { const unsigned blk = (lane >> 4) & 1u, q = (lane & 15u) >> 2, p = lane & 3u; return offb(rowbase + q, 4u * c + 2u * blk + (p >> 1)) + 8u * (p & 1u); }
typedef short v4i16_t __attribute__((ext_vector_type(4)));
DI s16x4 trrd(const LAS unsigned char* p) { return __builtin_bit_cast(s16x4, __builtin_amdgcn_ds_read_tr16_b64_v4i16((LAS v4i16_t*)p)); }
DI bf16x8 cat8(s16x4 lo, s16x4 hi) { return (bf16x8){lo[0], lo[1], lo[2], lo[3], hi[0], hi[1], hi[2], hi[3]}; }
DI bf16x8 tr_nat(const LAS unsigned char* img, unsigned lane, unsigned R0, unsigned c) { const unsigned h = lane >> 5; return cat8(trrd(img + tr_addr(lane, R0 + 8u * h, c)), trrd(img + tr_addr(lane, R0 + 8u * h + 4u, c))); }
DI bf16x8 tr_perm(const LAS unsigned char* img, unsigned lane, unsigned R0, unsigned c) { const unsigned h = lane >> 5; return cat8(trrd(img + tr_addr(lane, R0 + 4u * h, c)), trrd(img + tr_addr(lane, R0 + 8u + 4u * h, c))); }
DI bf16x8 pack8(const f32x16& x, int s) {
    v4u p; p.x = cvtpk(x[8 * s], x[8 * s + 1]); p.y = cvtpk(x[8 * s + 2], x[8 * s + 3]); p.z = cvtpk(x[8 * s + 4], x[8 * s + 5]); p.w = cvtpk(x[8 * s + 6], x[8 * s + 7]); return __builtin_bit_cast(bf16x8, p); }
DI int crow(int r, int hi) { return (r & 3) + 8 * (r >> 2) + 4 * hi; }

struct Frame {
    LAS unsigned char* lds;
    volatile LAS unsigned* MISC;
    gu32* ctl;
    int tid, lane, wave;
    int vcu, G;
    const float *x, *norm_pre, *w_in, *b_gate, *conv_w, *conv_b, *dt_bias, *a_log, *d_skip, *ssd_norm, *w_ssd, *w_sb, *w_out, *norm_post;
    float* out;
    bf16 *Win_t, *Wg_t, *Wssd_t, *Wsb_t, *Wout_t;
    bf16 *XN, *XBC, *XC, *QB, *KB, *VB, *ZS, *ZB, *MG1, *MG2;
    float *DT, *SSQ;
};

DI float wave_sum(float v) {
#pragma unroll
    for (int o = 1; o < 64; o <<= 1) v += __shfl_xor(v, o);
    return v;
}
DI int src_col_inproj(int n) { return n < 2560 ? n : (n < 6656 ? n + 16 : (n < 6672 ? n - 6656 + 2560 : -1)); }
DI void p0_transpose_item(const float* W, int ldw, int K, bf16* WT, int n0, int k0, int mode, const float* kscale, LAS float* scr, int lane) {
    const int nl = lane & 31; const int sc = mode == 1 ? src_col_inproj(n0 + nl) : (mode == 2 ? 6672 + n0 + nl : n0 + nl);
#pragma unroll 8
    for (int i = 0; i < 32; ++i) { const int kk = 2 * i + (lane >> 5); float v = sc >= 0 ? W[(size_t)(k0 + kk) * ldw + sc] : 0.f; if (kscale) v *= kscale[k0 + kk]; scr[kk * 33 + nl] = v; }
    LDS_WAIT(); asm volatile("" ::: "memory");
    const int c = lane & 7;
#pragma unroll
    for (int j = 0; j < 4; ++j) { const int n = (lane >> 3) + 8 * j; const LAS float* s = scr + (8 * c) * 33 + n;
        v4u o; o.x = pk2(s[0 * 33], s[1 * 33]); o.y = pk2(s[2 * 33], s[3 * 33]); o.z = pk2(s[4 * 33], s[5 * 33]); o.w = pk2(s[6 * 33], s[7 * 33]);
        *(GAS v4u*)(WT + (size_t)(n0 + n) * K + k0 + 8 * c) = o; }
    LDS_WAIT(); asm volatile("" ::: "memory");
}
DI void p0_prologue(Frame& F) {
    LAS float* scr = (LAS float*)(F.lds + RING_OFF + F.wave * 16384);
    const int gw = F.vcu * NWAVES + F.wave, NGW = F.G * NWAVES;
    constexpr int I_IN = (NPROJ / 32) * 16, I_G = 64 * 16, I_P = 32 * 16;
    constexpr int NITEMS = I_IN + I_G + 3 * I_P;
    for (int it = gw; it < NITEMS; it += NGW) {
        int r = it;
        if (r < I_IN) { p0_transpose_item(F.w_in, 8720, 1024, F.Win_t, (r >> 4) * 32, (r & 15) * 64, 1, nullptr, scr, F.lane); continue; } r -= I_IN;
        if (r < I_G) { p0_transpose_item(F.w_in, 8720, 1024, F.Wg_t, (r >> 4) * 32, (r & 15) * 64, 2, nullptr, scr, F.lane); continue; } r -= I_G;
        if (r < I_P) { p0_transpose_item(F.w_ssd, 1024, 1024, F.Wssd_t, (r >> 4) * 32, (r & 15) * 64, 0, F.ssd_norm, scr, F.lane); continue; } r -= I_P;
        if (r < I_P) { p0_transpose_item(F.w_sb, 1024, 1024, F.Wsb_t, (r >> 4) * 32, (r & 15) * 64, 0, nullptr, scr, F.lane); continue; } r -= I_P;
        p0_transpose_item(F.w_out, 1024, 1024, F.Wout_t, (r >> 4) * 32, (r & 15) * 64, 0, nullptr, scr, F.lane);
    }
    f32x4 wv[4];
#pragma unroll
    for (int j = 0; j < 4; ++j) wv[j] = ((const GAS f32x4*)F.norm_pre)[F.lane + 64 * j];
    for (int m = gw; m < M; m += NGW) {
        const GAS f32x4* xr = (const GAS f32x4*)(F.x + (size_t)m * DMODEL) + F.lane;
        f32x4 v[4]; float s = 0.f;
#pragma unroll
        for (int j = 0; j < 4; ++j) { v[j] = xr[64 * j]; s += (v[j].x * v[j].x + v[j].y * v[j].y) + (v[j].z * v[j].z + v[j].w * v[j].w); }
        const float rs = 1.f / sqrtf(wave_sum(s) * (1.f / DMODEL) + EPS);
        GAS unsigned long long* o8 = (GAS unsigned long long*)(F.XN + (size_t)m * DMODEL) + F.lane;
#pragma unroll
        for (int j = 0; j < 4; ++j) { const f32x4 o = v[j] * rs * wv[j]; o8[64 * j] = (unsigned long long)pk2(o.x, o.y) | ((unsigned long long)pk2(o.z, o.w) << 32); }
    }
}

DI void p2a_conv(Frame& F) {
    const int gt = F.vcu * NWAVES * 64 + F.tid, NT = F.G * NWAVES * 64;
    constexpr int TB = 16, NITEMS = (M / TB) * (CONVD / 8);
    for (int it = gt; it < NITEMS; it += NT) {
        const int cc = it % (CONVD / 8), blk = it / (CONVD / 8); const int c0 = cc * 8, t0 = blk * TB; const int ts = t0 % SEQ;
        float w[4][8], bias[8];
#pragma unroll
        for (int j = 0; j < 4; ++j) { const f32x4 a = *(const GAS f32x4*)(F.conv_w + j * CONVD + c0), b = *(const GAS f32x4*)(F.conv_w + j * CONVD + c0 + 4);
            w[j][0] = a.x; w[j][1] = a.y; w[j][2] = a.z; w[j][3] = a.w; w[j][4] = b.x; w[j][5] = b.y; w[j][6] = b.z; w[j][7] = b.w; }
        { const f32x4 a = *(const GAS f32x4*)(F.conv_b + c0), b = *(const GAS f32x4*)(F.conv_b + c0 + 4); bias[0] = a.x; bias[1] = a.y; bias[2] = a.z; bias[3] = a.w; bias[4] = b.x; bias[5] = b.y; bias[6] = b.z; bias[7] = b.w; }
        const GAS v4u* src = (const GAS v4u*)(F.XBC + (size_t)t0 * CONVD + c0);
        GAS v4u* dst = (GAS v4u*)(F.XC + (size_t)t0 * CONVD + c0);
        const v4u zero = (v4u){0u, 0u, 0u, 0u};
        v4u r0 = ts >= 3 ? src[-3 * (CONVD / 8)] : zero, r1 = ts >= 2 ? src[-2 * (CONVD / 8)] : zero, r2 = ts >= 1 ? src[-1 * (CONVD / 8)] : zero;
#pragma unroll
        for (int i = 0; i < TB; ++i) {
            const v4u r3 = src[i * (CONVD / 8)];
            float o[8];
#pragma unroll
            for (int e = 0; e < 4; ++e) {
                const unsigned a0 = r0[e], a1 = r1[e], a2 = r2[e], a3 = r3[e];
                const float lo = bias[2 * e] + w[0][2 * e] * bflo(a0) + w[1][2 * e] * bflo(a1) + w[2][2 * e] * bflo(a2) + w[3][2 * e] * bflo(a3);
                const float hi = bias[2 * e + 1] + w[0][2 * e + 1] * bfhi(a0) + w[1][2 * e + 1] * bfhi(a1) + w[2][2 * e + 1] * bfhi(a2) + w[3][2 * e + 1] * bfhi(a3);
                o[2 * e] = silu_f(lo); o[2 * e + 1] = silu_f(hi);
            }
            v4u ov; ov.x = cvtpk(o[0], o[1]); ov.y = cvtpk(o[2], o[3]); ov.z = cvtpk(o[4], o[5]); ov.w = cvtpk(o[6], o[7]);
            dst[i * (CONVD / 8)] = ov;
            r0 = r1; r1 = r2; r2 = r3;
        }
    }
}

constexpr int S_IMB = 0, S_IMC = 16384, S_IMX = 32768, S_IMS = 49152, S_PV = 65536, S_TAB = 98304, S_IMG = 108544;
#define BAR_LDS() do { asm volatile("s_waitcnt lgkmcnt(0)" ::: "memory"); __builtin_amdgcn_s_barrier(); asm volatile("" ::: "memory"); } while (0)
DI void ssd_unit(Frame& F, int b, int h, bool dry) {
    LAS unsigned char* L = F.lds + RING_OFF;
    const int wid = F.wave, g = h >> 3;
    const float a = -expf(F.a_log[h]), dsk = F.d_skip[h];
    { const int tid = F.tid; for (int i = tid; i < 16384 / 16; i += 512) *(LAS v4u*)(L + S_PV + i * 16) = (v4u){0u, 0u, 0u, 0u}; }
    f32x16 st0 = {}, st1 = {};
    v4u pfB[4], pfX, pfZ; float pfD;
#define SSD_PREFETCH(cc) do { const size_t tp = (size_t)b * SEQ + (size_t)(cc) * CHUNK; const int tid_ = F.tid; \
        _Pragma("unroll") for (int k = 0; k < 4; ++k) { const int idx = tid_ + 512 * k, which = idx >> 10, i2 = idx & 1023, row = i2 >> 4, ch = i2 & 15; \
            pfB[k] = *(const GAS v4u*)(F.XC + (tp + row) * CONVD + 1024 + which * 256 + g * NS + ch * 8); } \
        { const int row = tid_ >> 3, ch = tid_ & 7; pfX = *(const GAS v4u*)(F.XC + (tp + row) * CONVD + h * HP + ch * 8); pfZ = *(const GAS v4u*)(F.ZS + (tp + row) * DMODEL + h * HP + ch * 8); } \
        pfD = F.DT[(tp + (tid_ & 63)) * 16 + h]; } while (0)
#define SSD_STORE(cc) do { const size_t tp = (size_t)b * SEQ + (size_t)(cc) * CHUNK; const int tid_ = F.tid, row = tid_ >> 3, ch = tid_ & 7; \
        const v4u gv = *(const LAS v4u*)(L + S_IMG + offb(row, ch)); float q = 0.f; \
        _Pragma("unroll") for (int e = 0; e < 4; ++e) { const float lo = bflo(gv[e]), hi = bfhi(gv[e]); q += lo * lo + hi * hi; } \
        q += __shfl_xor(q, 1); q += __shfl_xor(q, 2); q += __shfl_xor(q, 4); \
        if (!dry) { *(GAS v4u*)(F.ZS + (tp + row) * DMODEL + h * HP + ch * 8) = gv; if (ch == 0) F.SSQ[(tp + row) * 16 + h] = q; } } while (0)
    SSD_PREFETCH(0);
    for (int c = 0; c < SEQ / CHUNK; ++c) {
        int tid = F.tid; asm volatile("" : "+v"(tid));
        const int lane = tid & 63, r = lane & 31, hh = lane >> 5;
        if (c > 0) SSD_STORE(c - 1);
        const float dtl = pfD; float cs = dtl * a;
#pragma unroll
        for (int o = 1; o < 64; o <<= 1) { const float up = __shfl_up(cs, o); if (lane >= o) cs += up; }
        const float tot = __shfl(cs, 63);
        const float dec_l = fexp2((tot - cs) * LOG2E) * dtl;
        LAS float* tab = (LAS float*)(L + S_TAB) + wid * 320;
        if (wid < 4) { tab[lane] = cs; tab[64 + lane] = fexp2(cs * LOG2E); }
#pragma unroll
        for (int k = 0; k < 4; ++k) { const int idx = tid + 512 * k, which = idx >> 10, i2 = idx & 1023, row = i2 >> 4, ch = i2 & 15; *(LAS v4u*)(L + (which ? S_IMC : S_IMB) + offb(row, ch)) = pfB[k]; }
        { const int row = tid >> 3, ch = tid & 7; const float dtr = __shfl(dtl, row), dcr = __shfl(dec_l, row);
            v4u o1, o2;
#pragma unroll
            for (int e = 0; e < 4; ++e) { const float lo = bflo(pfX[e]), hi = bfhi(pfX[e]); o1[e] = cvtpk(lo * dtr, hi * dtr); o2[e] = cvtpk(lo * dcr, hi * dcr); }
            *(LAS v4u*)(L + S_IMS + offb(row, ch)) = pfX; *(LAS v4u*)(L + S_IMS + offb(row, 8 + ch)) = pfZ;
            *(LAS v4u*)(L + S_IMX + offb(row, ch)) = o1; *(LAS v4u*)(L + S_IMX + offb(row, 8 + ch)) = o2; }
        BAR_LDS();
        if (c + 1 < SEQ / CHUNK) SSD_PREFETCH(c + 1);
        if (wid < 4) {
            const int lb = wid >> 1, pb = wid & 1;
            const LAS unsigned char* PV = L + S_PV + (c & 1) * 16384;
            bf16x8 Cf[8];
#pragma unroll
            for (int s = 0; s < 8; ++s) Cf[s] = *(const LAS bf16x8*)(L + S_IMC + offb(32 * lb + r, 2 * s + hh));
            f32x16 acc = {};
#pragma unroll
            for (int s = 0; s < 8; ++s) { const bf16x8 Pf = *(const LAS bf16x8*)(PV + offb(32 * pb + r, 2 * s + hh)); acc = MFMA32(Cf[s], Pf, acc); }
#pragma unroll
            for (int i = 0; i < 16; ++i) acc[i] *= tab[64 + 32 * lb + crow(i, hh)];
            const float al = tab[32 * lb + r];
            for (int sb = 0; sb <= lb; ++sb) {
                f32x16 X = {};
#pragma unroll
                for (int s = 0; s < 8; ++s) { const bf16x8 Bf = *(const LAS bf16x8*)(L + S_IMB + offb(32 * sb + r, 2 * s + hh)); X = MFMA32(Bf, Cf[s], X); }
#pragma unroll
                for (int i = 0; i < 16; ++i) { const int srow = 32 * sb + crow(i, hh); const float as = tab[srow]; const float dcy = fexp2((al - as) * LOG2E); X[i] = (srow <= 32 * lb + r) ? X[i] * dcy : 0.f; }
#pragma unroll
                for (int s2 = 0; s2 < 2; ++s2) { const bf16x8 Af = pack8(X, s2); const bf16x8 Xf = tr_perm(L + S_IMX, lane, 32 * sb + 16 * s2, pb); acc = MFMA32(Af, Xf, acc); }
            }
#pragma unroll
            for (int i = 0; i < 16; ++i) { const int l = 32 * lb + crow(i, hh), p = 32 * pb + r;
                const float xv = bf2f(*(const LAS unsigned short*)(L + S_IMS + offb(l, p >> 3) + (p & 7) * 2));
                const float z = bf2f(*(const LAS unsigned short*)(L + S_IMS + offb(l, 8 + (p >> 3)) + (p & 7) * 2));
                const float gy = (acc[i] + dsk * xv) * z;
                *(LAS unsigned short*)(L + S_IMG + offb(l, p >> 3) + (p & 7) * 2) = (unsigned short)f2bf(gy); }
        } else {
            const int nb = wid - 4; const float cd = fexp2(tot * LOG2E);
            LAS unsigned char* PVn = L + S_PV + ((c + 1) & 1) * 16384;
#pragma unroll
            for (int i = 0; i < 16; ++i) { st0[i] *= cd; st1[i] *= cd; }
#pragma unroll
            for (int ks = 0; ks < 4; ++ks) { const bf16x8 Af = tr_nat(L + S_IMB, lane, 16 * ks, nb); const bf16x8 B0 = tr_nat(L + S_IMX, lane, 16 * ks, 2), B1 = tr_nat(L + S_IMX, lane, 16 * ks, 3);
                st0 = MFMA32(Af, B0, st0); st1 = MFMA32(Af, B1, st1); }
#pragma unroll
            for (int g4 = 0; g4 < 4; ++g4) { u32x2 w0, w1; w0.x = cvtpk(st0[4 * g4], st0[4 * g4 + 1]); w0.y = cvtpk(st0[4 * g4 + 2], st0[4 * g4 + 3]); w1.x = cvtpk(st1[4 * g4], st1[4 * g4 + 1]); w1.y = cvtpk(st1[4 * g4 + 2], st1[4 * g4 + 3]);
                *(LAS u32x2*)(PVn + offb(r, 4 * nb + g4) + 8 * hh) = w0; *(LAS u32x2*)(PVn + offb(32 + r, 4 * nb + g4) + 8 * hh) = w1; }
        }
        BAR_LDS();
    }
    SSD_STORE(SEQ / CHUNK - 1);
    BAR_LDS();
#undef SSD_PREFETCH
#undef SSD_STORE
}

constexpr int A_IMK = 0, A_IMV = 8192, A_FLG = 16384;
DI void attn_unit(Frame& F, int b, int h, int qb, bool dry) {
    LAS unsigned char* L = F.lds + RING_OFF;
    const int tid = F.tid, lane = F.lane, wid = F.wave, r = lane & 31, hh = lane >> 5;
    const size_t rowbase = (size_t)b * SEQ; const int q0 = qb * 256 + wid * 32;
    bf16x8 qr[4];
#pragma unroll
    for (int s = 0; s < 4; ++s) qr[s] = *(const GAS bf16x8*)(F.QB + (rowbase + q0 + r) * DMODEL + h * HP + 16 * s + 8 * hh);
    f32x16 o0 = {}, o1 = {}; float carry = 1.f;
    volatile LAS unsigned* flg = (volatile LAS unsigned*)(L + A_FLG);
    const int NT = qb * 4 + 4;
    for (int kt = NT - 1; kt >= 0; --kt) {
        { const int key = tid >> 3, ch = tid & 7; const size_t go = (rowbase + kt * 64 + key) * DMODEL + h * HP + ch * 8;
          const v4u kv = *(const GAS v4u*)(F.KB + go), vv = *(const GAS v4u*)(F.VB + go);
          *(LAS v4u*)(L + A_IMK + offb(key & 31, 8 * (key >> 5) + ch)) = kv; *(LAS v4u*)(L + A_IMV + offb(key & 31, 8 * (key >> 5) + ch)) = vv; }
        __syncthreads();
        const bool live = (kt * 64 < q0 + 31) && !__all(carry == 0.f);
        if (live) {
#pragma unroll
            for (int kb = 1; kb >= 0; --kb) {
                f32x16 p = {};
#pragma unroll
                for (int s = 0; s < 4; ++s) { const bf16x8 Kf = *(const LAS bf16x8*)(L + A_IMK + offb(r, 8 * kb + 2 * s + hh)); p = MFMA32(Kf, qr[s], p); }
                float rr[16], G[4], Go[4];
#pragma unroll
                for (int i = 0; i < 16; ++i) { const int key = kt * 64 + 32 * kb + crow(i, hh); const bool valid = key < q0 + r;
                    const float e = fexp2(fminf(p[i], 100.f)); const float rv = frcp(1.f + e);
                    rr[i] = valid ? rv : 1.f; p[i] = valid ? e * rv : 0.f; }
#pragma unroll
                for (int g4 = 0; g4 < 4; ++g4) { G[g4] = (rr[4 * g4] * rr[4 * g4 + 1]) * (rr[4 * g4 + 2] * rr[4 * g4 + 3]); Go[g4] = __shfl_xor(G[g4], 32); }
                float run = carry;
#pragma unroll
                for (int g4 = 3; g4 >= 0; --g4) {
                    const float f3 = hh ? run : run * Go[g4];
                    const float f2 = f3 * rr[4 * g4 + 3], f1 = f2 * rr[4 * g4 + 2], f0 = f1 * rr[4 * g4 + 1];
                    p[4 * g4 + 3] *= f3; p[4 * g4 + 2] *= f2; p[4 * g4 + 1] *= f1; p[4 * g4] *= f0;
                    run = run * (G[g4] * Go[g4]);
                }
                carry = run;
#pragma unroll
                for (int s2 = 0; s2 < 2; ++s2) { const bf16x8 Pf = pack8(p, s2);
                    const bf16x8 V0 = tr_perm(L + A_IMV, lane, 16 * s2, 2 * kb), V1 = tr_perm(L + A_IMV, lane, 16 * s2, 2 * kb + 1);
                    o0 = MFMA32(Pf, V0, o0); o1 = MFMA32(Pf, V1, o1); }
            }
        }
        const bool done = __all(carry == 0.f) != 0;
        if (lane == 0) flg[wid] = done ? 1u : 0u;
        __syncthreads();
        unsigned alldone = 1u;
#pragma unroll
        for (int w = 0; w < 8; ++w) alldone &= flg[w];
        if (alldone) break;
    }
#pragma unroll
    for (int i = 0; i < 16; ++i) { const int q = q0 + crow(i, hh);
        bf16* zp = F.ZB + (rowbase + q) * DMODEL + h * HP + r;
        const float z0 = bf2f(zp[0]), z1 = bf2f(zp[32]);
        if (!dry) { zp[0] = (bf16)f2bf(o0[i] * z0); zp[32] = (bf16)f2bf(o1[i] * z1); } }
    __syncthreads();
}

DI void p5_final(Frame& F) {
    const int gw = F.vcu * NWAVES + F.wave, NGW = F.G * NWAVES;
    f32x4 wv[4];
#pragma unroll
    for (int j = 0; j < 4; ++j) wv[j] = ((const GAS f32x4*)F.norm_post)[F.lane + 64 * j];
    for (int m = gw; m < M; m += NGW) {
        GAS f32x4* orow = (GAS f32x4*)(F.out + (size_t)m * DMODEL) + F.lane; const GAS f32x4* xr = (const GAS f32x4*)(F.x + (size_t)m * DMODEL) + F.lane;
        f32x4 v[4], xv[4]; float s = 0.f;
#pragma unroll
        for (int j = 0; j < 4; ++j) { v[j] = orow[64 * j]; xv[j] = xr[64 * j]; s += (v[j].x * v[j].x + v[j].y * v[j].y) + (v[j].z * v[j].z + v[j].w * v[j].w); }
        const float rs = 1.f / sqrtf(wave_sum(s) * (1.f / DMODEL) + EPS);
#pragma unroll
        for (int j = 0; j < 4; ++j) orow[64 * j] = xv[j] + v[j] * rs * wv[j];
    }
}

#ifndef MK_N_LAUNCHES
#define MK_N_LAUNCHES 1
#endif
constexpr int N_LAUNCHES = MK_N_LAUNCHES;
constexpr int PER_PHASE = 7;
struct Args { const float* in[14]; float* out; unsigned char* ws; int ph_lo, ph_hi; };
__global__ void __launch_bounds__(NWAVES * 64, 2) mk_fwd(Args args) {
    extern __shared__ __attribute__((aligned(16))) unsigned char lds[];
    Frame F;
    F.lds = (LAS unsigned char*)lds;
    F.MISC = (volatile LAS unsigned*)(F.lds + MISC_OFF);
    F.tid = threadIdx.x; F.lane = F.tid & 63; F.wave = __builtin_amdgcn_readfirstlane(F.tid >> 6);
    F.G = gridDim.x; { const int bx = blockIdx.x; F.vcu = (F.G % 8 == 0) ? (bx % 8) * (F.G / 8) + bx / 8 : bx; }
    unsigned char* ws = args.ws;
    F.ctl = (gu32*)(ws + WS_CTL);
    F.x = args.in[0]; F.norm_pre = args.in[1]; F.w_in = args.in[2]; F.b_gate = args.in[3]; F.conv_w = args.in[4]; F.conv_b = args.in[5]; F.dt_bias = args.in[6]; F.a_log = args.in[7];
    F.d_skip = args.in[8]; F.ssd_norm = args.in[9]; F.w_ssd = args.in[10]; F.w_sb = args.in[11]; F.w_out = args.in[12]; F.norm_post = args.in[13]; F.out = args.out;
    F.Win_t = (bf16*)(ws + WS_WIN); F.Wg_t = (bf16*)(ws + WS_WG); F.Wssd_t = (bf16*)(ws + WS_WSSD); F.Wsb_t = (bf16*)(ws + WS_WSB); F.Wout_t = (bf16*)(ws + WS_WOUT);
    F.XN = (bf16*)(ws + WS_XN); F.XBC = (bf16*)(ws + WS_XBC); F.XC = (bf16*)(ws + WS_XC); F.QB = (bf16*)(ws + WS_Q); F.KB = (bf16*)(ws + WS_K); F.VB = (bf16*)(ws + WS_V);
    F.ZS = (bf16*)args.out; F.ZB = (bf16*)args.out + (size_t)M * DMODEL; F.MG1 = (bf16*)(ws + WS_MG1); F.MG2 = (bf16*)(ws + WS_MG2);
    F.DT = (float*)(ws + WS_DT); F.SSQ = (float*)(ws + WS_SSQ);
    for (int u = F.tid; u < (LDS_BYTES - LDSCTL_OFF) / 4; u += NWAVES * 64) ((LAS unsigned*)(F.lds + LDSCTL_OFF))[u] = 0u;
    __syncthreads();
    XcdBarrier bar; bar.bar = (unsigned*)(F.ctl + CW_BAR); bar.x = 0; bar.st = nullptr;
    if (N_LAUNCHES != PER_PHASE) bar = xcd_barrier_post((unsigned*)(F.ctl + CW_BAR), F.MISC + 8);
#define GRID_BAR() do { if (N_LAUNCHES != PER_PHASE) xcd_barrier(bar); } while (0)
    const int lo = args.ph_lo, hi = args.ph_hi;
#define IN(k) (lo <= (k) && (k) < hi)
#define BOTH(k) (IN(k) && IN((k) + 1))

    if (IN(0)) {
#ifndef NO_P0
 p0_prologue(F);
#endif
#if PROBE_DUP & 1
 p0_prologue(F);
#endif
 if (BOTH(0)) GRID_BAR(); }

    if (IN(1)) {
        pg8::Gemm g{}; g.A[0] = g.A[1] = g.A[2] = g.A[3] = F.XN; g.Bt[0] = g.Bt[1] = g.Bt[2] = g.Bt[3] = F.Win_t; g.K = DMODEL;
        pg8::StaticOrder S; S.init(M, NPROJ, F.G, (int)blockIdx.x);
        pg8::EpiProj E{F.ZS, F.XBC, F.QB, F.KB, F.VB, F.ZB, F.DT, F.dt_bias, QSCALE};
#ifndef NO_P1
        pg8::gemm_phase<pg8::EpiProj, pg8::StaticOrder, true, true>(F.lds + RING_OFF, g, S, E);
#endif
#if PROBE_DUP & 2
        pg8::gemm_phase<pg8::EpiProj, pg8::StaticOrder, true, true>(F.lds + RING_OFF, g, S, E);
#endif
        if (BOTH(1)) GRID_BAR();
    }

#if PROBE_DUP & 32
    for (int eb = 0; eb < 6; ++eb) GRID_BAR();
#endif
    if (IN(2)) {
#ifndef NO_P2A
 p2a_conv(F);
#endif
#if PROBE_DUP & 4
 p2a_conv(F);
#endif
 if (BOTH(2)) GRID_BAR(); }

    if (IN(3)) {
        const int bx = (int)blockIdx.x;
        const bool never = args.ph_hi < 0;
#if PROBE_DUP & 64
        if (bx < 128) { const int sid = (bx & 7) * 16 + (bx >> 3); ssd_unit(F, sid >> 4, sid & 15, !never); }
#endif
#if PROBE_DUP & 128
        for (;;) {
            if (F.tid == 0) F.MISC[16] = __hip_atomic_fetch_add(F.ctl + CW_ATTQ + 64, 1u, RLX_AGENT);
            __syncthreads();
            const unsigned u = F.MISC[16];
            __syncthreads();
            if (u >= (unsigned)(BATCH * NH * (SEQ / 256))) break;
            const int qb = 7 - (int)(u >> 7), bh = (int)(u & 127);
            attn_unit(F, bh >> 4, bh & 15, qb, !never);
        }
#endif
        if (bx < 128) { const int sid = (bx & 7) * 16 + (bx >> 3);
#ifndef NO_SSD
 ssd_unit(F, sid >> 4, sid & 15, never);
#endif
 }
        for (;;) {
            if (F.tid == 0) F.MISC[16] = __hip_atomic_fetch_add(F.ctl + CW_ATTQ, 1u, RLX_AGENT);
            __syncthreads();
            const unsigned u = F.MISC[16];
            __syncthreads();
            if (u >= (unsigned)(BATCH * NH * (SEQ / 256))) break;
            const int qb = 7 - (int)(u >> 7), bh = (int)(u & 127);
#ifndef NO_ATT
            attn_unit(F, bh >> 4, bh & 15, qb, never);
#endif
        }
        if (BOTH(3)) GRID_BAR();
    }

    if (IN(4)) {
        pg8::QuadOrder S; S.init(M, DMODEL, F.G, (int)blockIdx.x);
        pg8::Unit u0; const bool has = S.next(0, u0);
        LAS float* rowfac = (LAS float*)(F.lds + ROWFAC_OFF);
        if (has && F.tid < 256) { const GAS f32x4* sp = (const GAS f32x4*)(F.SSQ + (size_t)(u0.pm * 256 + F.tid) * 16);
            const f32x4 a = sp[0], b2 = sp[1], c2 = sp[2], d2 = sp[3];
            const float s0 = (a.x + a.y + a.z + a.w) + (b2.x + b2.y + b2.z + b2.w), s1 = (c2.x + c2.y + c2.z + c2.w) + (d2.x + d2.y + d2.z + d2.w);
            const float r0 = 1.f / sqrtf(s0 * (1.f / 512.f) + EPS), r1 = 1.f / sqrtf(s1 * (1.f / 512.f) + EPS);
            rowfac[F.tid * 2] = r0 / r1; rowfac[F.tid * 2 + 1] = r1; }
        __syncthreads();
        pg8::Gemm g{}; g.A[0] = F.XN; g.A[1] = F.ZS; g.A[2] = F.XN; g.A[3] = F.ZB; g.Bt[0] = F.Wg_t; g.Bt[1] = F.Wssd_t; g.Bt[2] = F.Wg_t + (size_t)1024 * 1024; g.Bt[3] = F.Wsb_t; g.K = DMODEL;
        pg8::EpiMerge E{F.MG1, F.MG2, F.b_gate, (const LAS float*)rowfac};
#ifndef NO_P3
        pg8::gemm_phase<pg8::EpiMerge, pg8::QuadOrder, true, true>(F.lds + RING_OFF, g, S, E);
#endif
#if PROBE_DUP & 8
        pg8::gemm_phase<pg8::EpiMerge, pg8::QuadOrder, true, true>(F.lds + RING_OFF, g, S, E);
#endif
        if (BOTH(4)) GRID_BAR();
    }

    if (IN(5)) {
        pg8::Gemm g{}; g.A[0] = g.A[1] = g.A[2] = g.A[3] = F.MG2; g.Bt[0] = g.Bt[1] = g.Bt[2] = g.Bt[3] = F.Wout_t; g.K = DMODEL;
        pg8::StaticOrder S; S.init(M, DMODEL, F.G, (int)blockIdx.x);
        pg8::EpiF32 E{F.out, DMODEL};
#ifndef NO_P4
        pg8::gemm_phase<pg8::EpiF32, pg8::StaticOrder, true, true>(F.lds + RING_OFF, g, S, E);
#endif
#if PROBE_DUP & 16
        pg8::gemm_phase<pg8::EpiF32, pg8::StaticOrder, true, true>(F.lds + RING_OFF, g, S, E);
#endif
        if (BOTH(5)) GRID_BAR();
    }

    #ifndef NO_P5
    if (IN(6)) p5_final(F);
#endif
#undef IN
#undef BOTH
}

extern "C" void kernel_launch(void* const* d_in, const int* in_sizes, int n_in, void* d_out, int out_size, void* d_ws, size_t ws_size, hipStream_t stream) {
    static int grid = 0;
    if (grid == 0) {
        if (n_in != 14 || in_sizes[0] != M * DMODEL || out_size != M * DMODEL || ws_size < WS_END) { fprintf(stderr, "kernel_launch: unexpected shapes (n_in %d, in0 %d, out %d, ws %zu); nothing launched\n", n_in, n_in > 0 ? in_sizes[0] : -1, out_size, ws_size); grid = -1; return; }
        int dev = 0, cus = 0, per_cu = 0;
        if (hipGetDevice(&dev) != hipSuccess || hipDeviceGetAttribute(&cus, hipDeviceAttributeMultiprocessorCount, dev) != hipSuccess) { fprintf(stderr, "kernel_launch: device query failed\n"); grid = -1; return; }
        if (hipFuncSetAttribute((const void*)mk_fwd, hipFuncAttributeMaxDynamicSharedMemorySize, LDS_BYTES) != hipSuccess) { fprintf(stderr, "kernel_launch: hipFuncSetAttribute failed\n"); grid = -1; return; }
        if (hipOccupancyMaxActiveBlocksPerMultiprocessor(&per_cu, (const void*)mk_fwd, NWAVES * 64, LDS_BYTES) != hipSuccess || per_cu < 1) { fprintf(stderr, "kernel_launch: occupancy query says %d blocks per CU; nothing launched\n", per_cu); (void)hipGetLastError(); grid = -1; return; }
        grid = cus;
        if (grid != 256) fprintf(stderr, "kernel_launch: %d CUs; P3 assumes one N=1024 tile per workgroup (256)\n", grid);
    }
    if (grid < 0) return;
    if (hipMemsetAsync((char*)d_ws + WS_CTL, 0, CTL_ZERO_BYTES, stream) != hipSuccess) { fprintf(stderr, "kernel_launch: hipMemsetAsync failed\n"); return; }
    Args a{};
    for (int i = 0; i < 14; ++i) a.in[i] = (const float*)d_in[i];
    a.out = (float*)d_out; a.ws = (unsigned char*)d_ws;
    for (int li = 0; li < N_LAUNCHES; ++li) {
        a.ph_lo = (N_LAUNCHES == PER_PHASE) ? li : 0; a.ph_hi = (N_LAUNCHES == PER_PHASE) ? li + 1 : PER_PHASE;
        hipLaunchKernelGGL(mk_fwd, dim3(grid), dim3(NWAVES * 64), LDS_BYTES, stream, a);
        const hipError_t le = hipPeekAtLastError();
        if (le != hipSuccess) { fprintf(stderr, "kernel_launch: launch %d failed: %s\n", li, hipGetErrorName(le)); break; }
    }
}
```
